# Optimizing an MI355X kernel written in HIP

```python
import jax
import jax.numpy as jnp
from jax import lax
import numpy as np

D_MODEL = 1024
BATCH = 8
SEQ = 4096
DEPTH = 4

CTX_LEN = 256
GRID_W = 64
N_MIXERS = 3
N_ADA = 6
RMS_EPS = 1e-6

CONV_WIDTH = 3

ML_HEADS = 8
ML_DQK = 64
ML_DV = 128
ML_QK = ML_HEADS * ML_DQK
ML_V = ML_HEADS * ML_DV
ML_CHUNK = 64
GATE_CAP = 15.0
ML_IN = 2 * ML_QK + 2 * ML_V + 4 * ML_HEADS

MLA_HEADS = 8
MLA_NOPE = 128
MLA_ROPE = 64
MLA_V = 128
MLA_Q_LORA = 384
MLA_KV_LORA = 256
MLA_SCALE = (MLA_NOPE + MLA_ROPE) ** -0.5
ROPE_THETA = 10000.0
Q_BLOCK = 128

N_EXPERTS = 32
TOP_K = 4
MOE_FF = D_MODEL
SWIGLU_ALPHA = 1.702
SWIGLU_LIMIT = 7.0
MOE_BLOCK = 256

kernel_name = 'hybrid_conv_mlstm_mla_moe_dit'


def rms_norm(x, gain):
    xf = x.astype(jnp.float32)
    y = xf * lax.rsqrt(jnp.mean(xf * xf, axis=-1, keepdims=True) + RMS_EPS)
    return y.astype(x.dtype) * gain


def ada_params(cond, w, b):
    return jnp.split(jax.nn.silu(cond) @ w + b, N_ADA, axis=-1)


def axial_rope_tables(rows, dim):
    n_freq = dim // 4
    inv = ROPE_THETA ** (-jnp.arange(n_freq, dtype=jnp.float32) / n_freq)
    row = jnp.repeat(jnp.arange(rows, dtype=jnp.float32), GRID_W)
    col = jnp.tile(jnp.arange(GRID_W, dtype=jnp.float32), rows)
    a_r = row[:, None] * inv
    a_c = col[:, None] * inv
    ang = jnp.concatenate([a_r, a_r, a_c, a_c], axis=-1)
    return jnp.cos(ang), jnp.sin(ang)


def _rot_half(a):
    a1, a2 = jnp.split(a, 2, axis=-1)
    return jnp.concatenate([-a2, a1], axis=-1)


def apply_axial_rope(x, cos, sin):
    xr, xc = jnp.split(x, 2, axis=-1)
    rotated = jnp.concatenate([_rot_half(xr), _rot_half(xc)], axis=-1)
    return x * cos.astype(x.dtype) + rotated * sin.astype(x.dtype)


def short_conv_mixer(h, w_in, w_conv, w_out):
    L = h.shape[1]
    b_gate, c_gate, u = jnp.split(h @ w_in, 3, axis=-1)
    pad = (CONV_WIDTH - 1) // 2
    vp = jnp.pad(c_gate * u, ((0, 0), (pad, CONV_WIDTH - 1 - pad), (0, 0)))
    y = sum(vp[:, j:j + L] * w_conv[j] for j in range(CONV_WIDTH))
    return (b_gate * y) @ w_out


def mlstm_scan(q, k, v, log_i, log_f, state):
    Bn, Hn, L = q.shape[:3]
    nc = L // ML_CHUNK

    def chunks(a):
        a = a.astype(jnp.float32)
        a = a.reshape(a.shape[:2] + (nc, ML_CHUNK) + a.shape[3:])
        return jnp.moveaxis(a, 2, 0)

    tri = jnp.tril(jnp.ones((ML_CHUNK, ML_CHUNK), dtype=bool))

    def step(carry, inp):
        C, n, m = carry
        qc, kc, vc, ic, fc = inp
        b = jnp.cumsum(fc, axis=-1)
        d = jnp.where(tri, b[..., :, None] - b[..., None, :] + ic[..., None, :], -jnp.inf)
        inter = b + m[..., None]
        m_t = jnp.maximum(inter, jnp.max(d, axis=-1))
        s = jnp.einsum('bhtd,bhsd->bhts', qc, kc) * jnp.exp(d - m_t[..., None])
        a = jnp.exp(inter - m_t)
        num = jnp.einsum('bhts,bhsv->bhtv', s, vc) + a[..., None] * jnp.einsum('bhtd,bhdv->bhtv', qc, C)
        den = jnp.sum(s, axis=-1) + a * jnp.einsum('bhtd,bhd->bht', qc, n)
        h = num / jnp.maximum(jnp.abs(den), jnp.exp(-m_t))[..., None]
        b_last = b[..., -1]
        g = b_last[..., None] - b + ic
        m_new = jnp.maximum(b_last + m, jnp.max(g, axis=-1))
        decay = jnp.exp(b_last + m - m_new)
        wk = jnp.exp(g - m_new[..., None])
        C_new = decay[..., None, None] * C + jnp.einsum('bhs,bhsd,bhsv->bhdv', wk, kc, vc)
        n_new = decay[..., None] * n + jnp.einsum('bhs,bhsd->bhd', wk, kc)
        return (C_new, n_new, m_new), h

    state, h = lax.scan(step, state, tuple(chunks(a) for a in (q, k, v, log_i, log_f)))
    h = jnp.moveaxis(h, 0, 2).reshape(Bn, Hn, L, ML_DV)
    return h, state


def mlstm_mixer(hl, hc, w_in, b_gate, norm_g, w_out, with_ctx):
    def project(h):
        Bn, L, _ = h.shape
        q, k, v, o, g = jnp.split(h @ w_in, [ML_QK, 2 * ML_QK, 2 * ML_QK + ML_V, 2 * ML_QK + 2 * ML_V], axis=-1)
        heads = lambda a: a.reshape(Bn, L, ML_HEADS, -1).transpose(0, 2, 1, 3)
        g = GATE_CAP * jnp.tanh((g + b_gate).astype(jnp.float32) / GATE_CAP)
        g = g.reshape(Bn, L, 4, ML_HEADS).transpose(2, 0, 3, 1)
        fwd = (g[0], jax.nn.log_sigmoid(g[1]))
        bwd = (g[2], jax.nn.log_sigmoid(g[3]))
        return (heads(q) * ML_DQK ** -0.5, heads(k), heads(v)), o, fwd, bwd

    def zero_state(Bn):
        return (jnp.zeros((Bn, ML_HEADS, ML_DQK, ML_DV), jnp.float32),
                jnp.zeros((Bn, ML_HEADS, ML_DQK), jnp.float32),
                jnp.zeros((Bn, ML_HEADS), jnp.float32))

    flip = lambda a: jnp.flip(a, axis=2)

    def bidir(qkv, fwd, bwd, st_f, st_b):
        h_f, st_f = mlstm_scan(*qkv, *fwd, st_f)
        h_b, st_b = mlstm_scan(*[flip(a) for a in qkv], *[flip(a) for a in bwd], st_b)
        return h_f + flip(h_b), st_f, st_b

    def finish(h, o):
        Bn, _, L, _ = h.shape
        h = rms_norm(h, norm_g.reshape(ML_HEADS, 1, ML_DV))
        h = h.transpose(0, 2, 1, 3).reshape(Bn, L, ML_V).astype(o.dtype)
        return (jax.nn.sigmoid(o) * h) @ w_out

    Bn = hl.shape[0]
    qkv_c, o_c, fwd_c, bwd_c = project(hc)
    h_c, st_f, st_b = bidir(qkv_c, fwd_c, bwd_c, zero_state(Bn), zero_state(Bn))
    qkv_l, o_l, fwd_l, bwd_l = project(hl)
    h_l, _, _ = bidir(qkv_l, fwd_l, bwd_l, st_f, st_b)
    y_c = finish(h_c, o_c) if with_ctx else None
    return finish(h_l, o_l), y_c


def mla_attend(qn, qr, kn, kr, v):
    s = jnp.einsum('bhqd,bhkd->bhqk', qn, kn) + jnp.einsum('bhqr,bkr->bhqk', qr, kr)
    p = jax.nn.softmax(s.astype(jnp.float32) * MLA_SCALE, axis=-1)
    return jnp.einsum('bhqk,bhkv->bhqv', p.astype(v.dtype), v)


def mla_mixer(hl, hc, w_in, q_norm, kv_norm, w_uq, w_ukv, qn_nope, qn_rope, kn_nope, kn_rope,
              w_out, rope, with_ctx):
    def down(h):
        return jnp.split(h @ w_in, [MLA_Q_LORA, MLA_Q_LORA + MLA_KV_LORA], axis=-1)

    def heads(a):
        Bn, L, _ = a.shape
        return a.reshape(Bn, L, MLA_HEADS, -1).transpose(0, 2, 1, 3)

    def queries(cq, rope):
        q = heads(rms_norm(cq, q_norm) @ w_uq)
        qn = rms_norm(q[..., :MLA_NOPE], qn_nope)
        qr = rms_norm(q[..., MLA_NOPE:], qn_rope)
        if rope is not None:
            qr = apply_axial_rope(qr, *rope)
        return qn, qr

    def keys_values(ckv, kr, rope):
        kv = heads(rms_norm(ckv, kv_norm) @ w_ukv)
        kn = rms_norm(kv[..., :MLA_NOPE], kn_nope)
        kr = rms_norm(kr, kn_rope)
        if rope is not None:
            kr = apply_axial_rope(kr, *rope)
        return kn, kr, kv[..., MLA_NOPE:]

    def merge(o):
        Bn, _, L, _ = o.shape
        return o.transpose(0, 2, 1, 3).reshape(Bn, L, MLA_HEADS * MLA_V) @ w_out

    cq_l, ckv_l, kr_l = down(hl)
    cq_c, ckv_c, kr_c = down(hc)
    qn_l, qr_l = queries(cq_l, rope)
    kn_l, kr_l, v_l = keys_values(ckv_l, kr_l, rope)
    kn_c, kr_c, v_c = keys_values(ckv_c, kr_c, None)
    kn = jnp.concatenate([kn_l, kn_c], axis=2)
    kr = jnp.concatenate([kr_l, kr_c], axis=1)
    v = jnp.concatenate([v_l, v_c], axis=2)
    Bn, Hn, L, _ = qn_l.shape
    nb = L // Q_BLOCK
    blocks = lambda a: jnp.moveaxis(a.reshape(Bn, Hn, nb, Q_BLOCK, a.shape[-1]), 2, 0)
    o = lax.map(lambda qb: mla_attend(qb[0], qb[1], kn, kr, v), (blocks(qn_l), blocks(qr_l)))
    o_l = jnp.moveaxis(o, 0, 2).reshape(Bn, Hn, L, MLA_V)
    y_c = None
    if with_ctx:
        qn_c, qr_c = queries(cq_c, None)
        y_c = merge(mla_attend(qn_c, qr_c, kn_c, kr_c, v_c))
    return merge(o_l), y_c


def moe_ffn(h, w_r, b_r, w1, b1, w2, b2):
    T, D = h.shape
    logits = (h @ w_r + b_r).astype(jnp.float32)
    top_v, top_e = lax.top_k(logits, TOP_K)
    gates = jax.nn.softmax(top_v, axis=-1)
    flat_e = top_e.reshape(-1)
    order = jnp.argsort(flat_e)
    sorted_e = flat_e[order]
    sorted_tok = order // TOP_K
    sorted_gate = gates.reshape(-1)[order].astype(h.dtype)
    counts = jnp.bincount(flat_e, length=N_EXPERTS)
    group_start = jnp.cumsum(counts) - counts
    padded = (counts + MOE_BLOCK - 1) // MOE_BLOCK * MOE_BLOCK
    padded_end = jnp.cumsum(padded)
    padded_start = padded_end - padded
    dest = padded_start[sorted_e] + (jnp.arange(T * TOP_K) - group_start[sorted_e])
    n_rows = -(-(T * TOP_K) // MOE_BLOCK) * MOE_BLOCK + N_EXPERTS * MOE_BLOCK
    n_blk = n_rows // MOE_BLOCK
    xp = jnp.zeros((n_rows, D), h.dtype).at[dest].set(h[sorted_tok])
    blk_start = jnp.arange(n_blk) * MOE_BLOCK
    blk_e = jnp.minimum(jnp.sum(padded_end[None, :] <= blk_start[:, None], axis=1), N_EXPERTS - 1)

    def expert_block(args):
        xb, e = args
        glu, lin = jnp.split(xb @ w1[e] + b1[e], 2, axis=-1)
        glu = jnp.minimum(glu, SWIGLU_LIMIT)
        lin = jnp.clip(lin, -SWIGLU_LIMIT, SWIGLU_LIMIT)
        act = glu * jax.nn.sigmoid(SWIGLU_ALPHA * glu) * (lin + 1.0)
        return act @ w2[e] + b2[e]

    yp = lax.map(expert_block, (xp.reshape(n_blk, MOE_BLOCK, D), blk_e)).reshape(n_rows, D)
    y = yp[dest] * sorted_gate[:, None]
    return jnp.zeros_like(h).at[sorted_tok].add(y)


def setup_inputs(seed: int = 0) -> dict:
    key = jax.random.key(seed)
    ks = iter(jax.random.split(key, 48))
    nrm = lambda shape, scale: jax.random.normal(next(ks), shape, jnp.float32) * scale
    gain = lambda shape: 1.0 + nrm(shape, 0.05)
    n_conv = len(range(0, DEPTH, N_MIXERS))
    n_ml = len(range(1, DEPTH, N_MIXERS))
    n_mla = len(range(2, DEPTH, N_MIXERS))
    D = D_MODEL
    gate_offset = jnp.array([0.0, 3.0, 0.0, 3.0], jnp.float32)[None, :, None]
    return {
        'x': nrm((BATCH, SEQ, D), 1.0),
        'c': nrm((BATCH, D), 1.0),
        'ctx': nrm((BATCH, CTX_LEN, D), 1.0),
        'c_ctx': nrm((D,), 1.0),
        'norm_mix': gain((DEPTH, D)),
        'norm_ffn': gain((DEPTH, D)),
        'w_mod': nrm((DEPTH, D, N_ADA * D), 0.5 * D ** -0.5),
        'b_mod': nrm((DEPTH, N_ADA * D), 0.02),
        'conv_w_in': nrm((n_conv, D, 3 * D), D ** -0.5),
        'conv_w': nrm((n_conv, CONV_WIDTH, D), CONV_WIDTH ** -0.5),
        'conv_w_out': nrm((n_conv, D, D), D ** -0.5),
        'ml_w_in': nrm((n_ml, D, ML_IN), D ** -0.5),
        'ml_b_gate': (nrm((n_ml, 4, ML_HEADS), 0.3) + gate_offset).reshape(n_ml, 4 * ML_HEADS),
        'ml_norm': gain((n_ml, ML_V)),
        'ml_w_out': nrm((n_ml, ML_V, D), ML_V ** -0.5),
        'mla_w_in': nrm((n_mla, D, MLA_Q_LORA + MLA_KV_LORA + MLA_ROPE), D ** -0.5),
        'mla_q_norm': gain((n_mla, MLA_Q_LORA)),
        'mla_kv_norm': gain((n_mla, MLA_KV_LORA)),
        'mla_w_uq': nrm((n_mla, MLA_Q_LORA, MLA_HEADS * (MLA_NOPE + MLA_ROPE)), MLA_Q_LORA ** -0.5),
        'mla_w_ukv': nrm((n_mla, MLA_KV_LORA, MLA_HEADS * (MLA_NOPE + MLA_V)), MLA_KV_LORA ** -0.5),
        'mla_qn_nope': gain((n_mla, MLA_NOPE)),
        'mla_qn_rope': gain((n_mla, MLA_ROPE)),
        'mla_kn_nope': gain((n_mla, MLA_NOPE)),
        'mla_kn_rope': gain((n_mla, MLA_ROPE)),
        'mla_w_out': nrm((n_mla, MLA_HEADS * MLA_V, D), (MLA_HEADS * MLA_V) ** -0.5),
        'moe_w_router': nrm((DEPTH, D, N_EXPERTS), D ** -0.5),
        'moe_b_router': nrm((DEPTH, N_EXPERTS), 0.01),
        'moe_w1': nrm((DEPTH, N_EXPERTS, D, 2 * MOE_FF), D ** -0.5),
        'moe_b1': nrm((DEPTH, N_EXPERTS, 2 * MOE_FF), 0.01),
        'moe_w2': nrm((DEPTH, N_EXPERTS, MOE_FF, D), MOE_FF ** -0.5),
        'moe_b2': nrm((DEPTH, N_EXPERTS, D), 0.01),
    }


def reference(x, c, ctx, c_ctx, norm_mix, norm_ffn, w_mod, b_mod,
              conv_w_in, conv_w, conv_w_out,
              ml_w_in, ml_b_gate, ml_norm, ml_w_out,
              mla_w_in, mla_q_norm, mla_kv_norm, mla_w_uq, mla_w_ukv,
              mla_qn_nope, mla_qn_rope, mla_kn_nope, mla_kn_rope, mla_w_out,
              moe_w_router, moe_b_router, moe_w1, moe_b1, moe_w2, moe_b2):
    Bn, n_lat, D = x.shape
    rows = n_lat // GRID_W
    rope = axial_rope_tables(rows, MLA_ROPE)
    xc = ctx
    for layer in range(DEPTH):
        kind, j = layer % N_MIXERS, layer // N_MIXERS
        with_ctx = layer != DEPTH - 1
        sh_a, sc_a, g_a, sh_f, sc_f, g_f = [p[:, None, :] for p in ada_params(c, w_mod[layer], b_mod[layer])]
        csh_a, csc_a, cg_a, csh_f, csc_f, cg_f = ada_params(c_ctx, w_mod[layer], b_mod[layer])
        hl = rms_norm(x, norm_mix[layer]) * (1.0 + sc_a) + sh_a
        if with_ctx or kind != 0:
            hc = rms_norm(xc, norm_mix[layer]) * (1.0 + csc_a) + csh_a
        if kind == 0:
            yl = short_conv_mixer(hl, conv_w_in[j], conv_w[j], conv_w_out[j])
            yc = short_conv_mixer(hc, conv_w_in[j], conv_w[j], conv_w_out[j]) if with_ctx else None
        elif kind == 1:
            yl, yc = mlstm_mixer(hl, hc, ml_w_in[j], ml_b_gate[j], ml_norm[j], ml_w_out[j], with_ctx)
        else:
            yl, yc = mla_mixer(hl, hc, mla_w_in[j], mla_q_norm[j], mla_kv_norm[j], mla_w_uq[j],
                               mla_w_ukv[j], mla_qn_nope[j], mla_qn_rope[j], mla_kn_nope[j],
                               mla_kn_rope[j], mla_w_out[j], rope, with_ctx)
        x = x + g_a * yl
        hl = rms_norm(x, norm_ffn[layer]) * (1.0 + sc_f) + sh_f
        moe_w = (moe_w_router[layer], moe_b_router[layer], moe_w1[layer], moe_b1[layer],
                 moe_w2[layer], moe_b2[layer])
        if with_ctx:
            xc = xc + cg_a * yc
            hc = rms_norm(xc, norm_ffn[layer]) * (1.0 + csc_f) + csh_f
            n_ctx = Bn * xc.shape[1]
            y = moe_ffn(jnp.concatenate([hc.reshape(-1, D), hl.reshape(-1, D)], axis=0), *moe_w)
            xc = xc + cg_f * y[:n_ctx].reshape(xc.shape)
            x = x + g_f * y[n_ctx:].reshape(x.shape)
        else:
            x = x + g_f * moe_ffn(hl.reshape(-1, D), *moe_w).reshape(x.shape)
    return x
```

```cpp
#include <hip/hip_runtime.h>
#include <cstdio>
#include <cstdint>

#ifndef MK_PER_PHASE
#define MK_PER_PHASE 0
#endif

#define LAS __attribute__((address_space(3)))
typedef unsigned short bf16_t;
typedef short bf16x8 __attribute__((ext_vector_type(8)));
typedef short s16x4 __attribute__((ext_vector_type(4)));
typedef float f32x4 __attribute__((ext_vector_type(4)));
typedef float f32x2 __attribute__((ext_vector_type(2)));
typedef float f32x16 __attribute__((ext_vector_type(16)));
typedef unsigned u32x4 __attribute__((ext_vector_type(4)));
typedef unsigned u32x2 __attribute__((ext_vector_type(2)));

constexpr int D = 1024, NB = 8, SEQ = 4096, CTXL = 256;
constexpr int T_CTX = NB * CTXL, T_LAT = NB * SEQ, T_ALL = T_CTX + T_LAT;
constexpr int NEXP = 32;
constexpr int MOE_ROWS_MAX = T_ALL * 4 + NEXP * 256;
constexpr float RMS_EPS = 1e-6f;
constexpr int NCHUNK = 68;

__device__ __forceinline__ unsigned cvt_pk_bf16(float lo, float hi) { unsigned r; asm volatile("v_cvt_pk_bf16_f32 %0, %1, %2" : "=v"(r) : "v"(lo), "v"(hi)); return r; }
__device__ __forceinline__ float bflo(unsigned u) { return __uint_as_float(u << 16); }
__device__ __forceinline__ float bfhi(unsigned u) { return __uint_as_float(u & 0xffff0000u); }
__device__ __forceinline__ float bf1(bf16_t b) { return __uint_as_float(((unsigned)b) << 16); }
__device__ __forceinline__ bf16_t f2bf(float f) { return (bf16_t)(cvt_pk_bf16(f, 0.f) & 0xffffu); }
__device__ __forceinline__ float shx(float v, int o, int lane) { return __int_as_float(__builtin_amdgcn_ds_bpermute((lane ^ o) << 2, __float_as_int(v))); }
__device__ __forceinline__ int shxi(int v, int o, int lane) { return __builtin_amdgcn_ds_bpermute((lane ^ o) << 2, v); }
__device__ __forceinline__ float shup(float v, int o, int lane) { return __int_as_float(__builtin_amdgcn_ds_bpermute((lane - o) << 2, __float_as_int(v))); }
__device__ __forceinline__ float wave_sum(float v, int lane) {
#pragma unroll
    for (int o = 1; o < 64; o <<= 1) v += shx(v, o, lane);
    return v;
}
__device__ __forceinline__ float fast_exp(float x) { return __builtin_amdgcn_exp2f(x * 1.44269504088896f); }
__device__ __forceinline__ float fast_rcp(float x) { return __builtin_amdgcn_rcpf(x); }
__device__ __forceinline__ float sigmoidf_(float x) { return fast_rcp(1.0f + fast_exp(-x)); }
#define MFMA32(a, b, c) __builtin_amdgcn_mfma_f32_32x32x16_bf16((a), (b), (c), 0, 0, 0)
#define MFMA16(a, b, c) __builtin_amdgcn_mfma_f32_16x16x32_bf16((a), (b), (c), 0, 0, 0)
__device__ __forceinline__ bf16x8 pack8(const f32x16& x, int s) {
    u32x4 p;
    p[0] = cvt_pk_bf16(x[8 * s + 0], x[8 * s + 1]); p[1] = cvt_pk_bf16(x[8 * s + 2], x[8 * s + 3]);
    p[2] = cvt_pk_bf16(x[8 * s + 4], x[8 * s + 5]); p[3] = cvt_pk_bf16(x[8 * s + 6], x[8 * s + 7]);
    return __builtin_bit_cast(bf16x8, p);
}

typedef int v8i __attribute__((ext_vector_type(8)));
__device__ __forceinline__ v8i cat8(bf16x8 a, bf16x8 b) { const u32x4 x = __builtin_bit_cast(u32x4, a), y = __builtin_bit_cast(u32x4, b); return (v8i){(int)x.x, (int)x.y, (int)x.z, (int)x.w, (int)y.x, (int)y.y, (int)y.z, (int)y.w}; }
__device__ __forceinline__ unsigned pk_fp8x4(float a, float b, float c, float d) { int p = 0; p = __builtin_amdgcn_cvt_pk_fp8_f32(a, b, p, false); p = __builtin_amdgcn_cvt_pk_fp8_f32(c, d, p, true); return (unsigned)p; }
constexpr float W8_SCALE = 64.0f, W8_INV = 1.0f / 64.0f;
template <bool F8> struct FragSel { typedef v8i A; };
__device__ __forceinline__ bf16x8 half8(const v8i& v, int k) { const u32x4 t = k ? (u32x4){(unsigned)v[4], (unsigned)v[5], (unsigned)v[6], (unsigned)v[7]} : (u32x4){(unsigned)v[0], (unsigned)v[1], (unsigned)v[2], (unsigned)v[3]}; return __builtin_bit_cast(bf16x8, t); }
namespace pg8 {
constexpr int BM = 256, BK = 64, HALF = 128, HTB = HALF * BK * 2, STAGE_BYTES = 8 * HTB, NXCD = 8, WGM = 8;
__host__ __device__ __forceinline__ int lds_byte(int r, int c) { const int st = (r >> 4) * 2 + (c >> 5), rr = r & 15, cc = c & 31, ob = rr * 64 + cc * 2; return st * 1024 + (ob ^ (((ob >> 9) & 1) << 5)); }
__host__ __device__ __forceinline__ void stage_rc(int b, int& R, int& C) { const int st = b / 1024, sb = b % 1024, swz = sb ^ (((sb >> 9) & 1) << 5); R = (st >> 1) * 16 + swz / 64; C = (st & 1) * 32 + (swz % 64) / 2; }
__host__ __device__ __forceinline__ int perm32(int rho) { const int n = rho >> 4, i = rho & 15; return 8 * (i >> 2) + 4 * n + (i & 3); }

struct Unit { int pm, pn, e; };

struct SchedPlain {
    const char* A; const char* B; int K; int nM, nN, nwg, G, c, pm0; unsigned mnig;
    __device__ __forceinline__ void init(const void* A_, const void* B_, int K_, int nM_, int nN_, int G_, int c_, int pm0_) { A = (const char*)A_; B = (const char*)B_; K = K_; nM = nM_; nN = nN_; nwg = nM * nN; G = G_; c = c_; pm0 = pm0_;
        mnig = (unsigned)((0x100000000ull + (unsigned)(WGM * nN) - 1u) / (unsigned)(WGM * nN)); }
    __device__ __forceinline__ bool next(int i, Unit& u) const {
        const long L = (long)i * G + c; if (L >= nwg) return false;
        int wgid = (int)L; { const int q = nwg / NXCD, r = nwg % NXCD, xcd = wgid % NXCD, off = wgid / NXCD; wgid = (xcd < r ? xcd * (q + 1) : r * (q + 1) + (xcd - r) * q) + off; }
        const int nig = WGM * nN, gid = (int)(((unsigned long long)(unsigned)wgid * mnig) >> 32), rem = wgid - gid * nig, fm = gid * WGM, gsz = (nM - fm) < WGM ? (nM - fm) : WGM;
        if (gsz == WGM) { u.pm = pm0 + fm + (rem & (WGM - 1)); u.pn = rem >> 3; } else { u.pm = pm0 + fm + rem % gsz; u.pn = rem / gsz; }
        u.e = 0; return true;
    }
    __device__ __forceinline__ const char* a_base(const Unit& u) const { return A + (size_t)u.pm * (size_t)(BM * 2) * K; }
    __device__ __forceinline__ const char* b_base(const Unit& u) const { return B + (size_t)u.pn * (size_t)(BM * 2) * K; }
    __device__ __forceinline__ void tok_off(const Unit& u, const int (&R)[2], const unsigned (&coff)[2], unsigned (&o)[2][2]) const {
#pragma unroll
        for (int h = 0; h < 2; ++h)
#pragma unroll
            for (int i = 0; i < 2; ++i) o[h][i] = (unsigned)(u.pm * 256 + h * 128 + R[i]) * (unsigned)(K * 2) + coff[i];
    }
};
constexpr int MI_PEXP_REL = 1152 - 16;
struct SchedMoe {
    const char* A; const char* W; size_t wstride; int K, NT, nunits, G, c; const LAS int* ppre; const LAS int* ecnt; const int* list;
    int xa, jq, jr, ppx;
    __device__ __forceinline__ void prep() {
        if ((G & 7) == 0 && ((G >> 3) % NT) == 0) { const int j = c >> 3; xa = c & 7; ppx = (G >> 3) / NT; jq = j / NT; jr = j % NT; } else { xa = 0; jq = 0; jr = 0; ppx = 0; }
    }
    __device__ __forceinline__ bool next(int i, Unit& u) const {
        int p, pn;
        if (ppx != 0) {
            p = (i * 8 + xa) * ppx + jq; pn = jr;
            if (p * NT >= nunits) return false;
        } else {
            const long L = (long)i * G + c; if (L >= nunits) return false;
            p = (int)(L / NT); pn = (int)(L % NT);
        }
        u.pm = p; u.pn = pn;
        u.e = __builtin_amdgcn_readfirstlane(ppre[MI_PEXP_REL + p]); return true;
    }
    __device__ __forceinline__ const char* a_base(const Unit& u) const { return A + (size_t)u.pm * (size_t)(BM * 2) * K; }
    __device__ __forceinline__ const char* b_base(const Unit& u) const { return W + (size_t)u.e * wstride + (size_t)u.pn * (size_t)(BM * 2) * K; }
    __device__ __forceinline__ void tok_off(const Unit& u, const int (&R)[2], const unsigned (&coff)[2], unsigned (&o)[2][2]) const {
        if (list == nullptr) {
#pragma unroll
            for (int h = 0; h < 2; ++h)
#pragma unroll
                for (int i = 0; i < 2; ++i) o[h][i] = (unsigned)(u.pm * 256 + h * 128 + R[i]) * (unsigned)(K * 2) + coff[i];
            return;
        }
        const int base = (u.pm - __builtin_amdgcn_readfirstlane(ppre[u.e])) * 256, cn = __builtin_amdgcn_readfirstlane(ecnt[u.e]); const int* lp = list + (size_t)u.e * T_ALL;
#pragma unroll
        for (int h = 0; h < 2; ++h)
#pragma unroll
            for (int i = 0; i < 2; ++i) { const int pos = base + h * 128 + R[i]; o[h][i] = (unsigned)lp[pos < cn ? pos : 0] * (unsigned)(K * 2) + coff[i]; }
    }
};

struct EpiF32 {
    static constexpr bool PERM = false;
    float* C; int ldc;
    __device__ __forceinline__ void operator()(const f32x4 (&acc)[2][2][4][2], const Unit& u, int wr, int wc, int fr, int fq) const {
        const int row0 = u.pm * BM + wr * 64 + fr, col0 = u.pn * BM + wc * 32 + 4 * fq;
#pragma unroll
        for (int ai = 0; ai < 2; ++ai)
#pragma unroll
            for (int m = 0; m < 4; ++m) { float* rowp = C + (size_t)(row0 + ai * HALF + m * 16) * ldc + col0;
#pragma unroll
                for (int bj = 0; bj < 2; ++bj)
#pragma unroll
                    for (int n = 0; n < 2; ++n) *(f32x4*)(rowp + bj * HALF + n * 16) = acc[ai][bj][m][n]; }
    }
};
struct EpiBf16 {
    static constexpr bool PERM = true;
    bf16_t* O; int ldc; float scale; int blk_nf;
    __device__ __forceinline__ void operator()(const f32x4 (&acc)[2][2][4][2], const Unit& u, int wr, int wc, int fr, int fq) const {
        const int row0 = u.pm * BM + wr * 64 + fr, col0 = u.pn * BM + wc * 32 + 8 * fq;
#pragma unroll
        for (int ai = 0; ai < 2; ++ai)
#pragma unroll
            for (int m = 0; m < 4; ++m) { const int row = row0 + ai * HALF + m * 16;
#pragma unroll
                for (int bj = 0; bj < 2; ++bj) { const f32x4 v0 = acc[ai][bj][m][0] * scale, v1 = acc[ai][bj][m][1] * scale; const int col = col0 + bj * HALF;
                    u32x4 w; w.x = cvt_pk_bf16(v0[0], v0[1]); w.y = cvt_pk_bf16(v0[2], v0[3]); w.z = cvt_pk_bf16(v1[0], v1[1]); w.w = cvt_pk_bf16(v1[2], v1[3]);
                    bf16_t* p = blk_nf ? O + ((size_t)(col >> 6) * blk_nf + row) * 64 + (col & 63) : O + (size_t)row * ldc + col;
                    *(u32x4*)p = w; } }
    }
};
struct EpiVt8 {
    static constexpr bool PERM = true;
    unsigned char* O;
    __device__ __forceinline__ void operator()(const f32x4 (&acc)[2][2][4][2], const Unit& u, int wr, int wc, int fr, int fq) const {
        const int row0 = u.pm * BM + wr * 64 + fr, col0 = u.pn * BM + wc * 32 + 8 * fq;
#pragma unroll
        for (int ai = 0; ai < 2; ++ai)
#pragma unroll
            for (int m = 0; m < 4; ++m) { const int row = row0 + ai * HALF + m * 16;
#pragma unroll
                for (int bj = 0; bj < 2; ++bj) { const f32x4 v0 = acc[ai][bj][m][0], v1 = acc[ai][bj][m][1]; const int col = col0 + bj * HALF, kap = col & 63;
                    unsigned char* p = O + ((size_t)(col >> 6) * 1024 + row) * 64 + 16 * (kap >> 5) + 4 * ((kap & 31) >> 3);
                    *(unsigned*)p = pk_fp8x4(__builtin_amdgcn_fmed3f(v0[0], -448.f, 448.f), __builtin_amdgcn_fmed3f(v0[1], -448.f, 448.f), __builtin_amdgcn_fmed3f(v0[2], -448.f, 448.f), __builtin_amdgcn_fmed3f(v0[3], -448.f, 448.f));
                    *(unsigned*)(p + 32) = pk_fp8x4(__builtin_amdgcn_fmed3f(v1[0], -448.f, 448.f), __builtin_amdgcn_fmed3f(v1[1], -448.f, 448.f), __builtin_amdgcn_fmed3f(v1[2], -448.f, 448.f), __builtin_amdgcn_fmed3f(v1[3], -448.f, 448.f)); } }
    }
};
struct EpiConvIn {
    static constexpr bool PERM = true;
    bf16_t* BG; bf16_t* V;
    __device__ __forceinline__ void operator()(const f32x4 (&acc)[2][2][4][2], const Unit& u, int wr, int wc, int fr, int fq) const {
        const int row0 = u.pm * BM + wr * 64 + fr;
        if (u.pn < 4) {
            const int col0 = u.pn * BM + wc * 32 + 8 * fq;
#pragma unroll
            for (int ai = 0; ai < 2; ++ai)
#pragma unroll
                for (int m = 0; m < 4; ++m) { bf16_t* rowp = BG + (size_t)(row0 + ai * HALF + m * 16) * D + col0;
#pragma unroll
                    for (int bj = 0; bj < 2; ++bj) { const f32x4 v0 = acc[ai][bj][m][0], v1 = acc[ai][bj][m][1];
                        u32x4 w; w.x = cvt_pk_bf16(v0[0], v0[1]); w.y = cvt_pk_bf16(v0[2], v0[3]); w.z = cvt_pk_bf16(v1[0], v1[1]); w.w = cvt_pk_bf16(v1[2], v1[3]);
                        *(u32x4*)(rowp + bj * HALF) = w; } }
        } else {
            const int ch0 = (u.pn - 4) * HALF + wc * 32 + 8 * fq;
#pragma unroll
            for (int ai = 0; ai < 2; ++ai)
#pragma unroll
                for (int m = 0; m < 4; ++m) { bf16_t* rowp = V + (size_t)(row0 + ai * HALF + m * 16) * D + ch0;
                    const f32x4 v0 = acc[ai][0][m][0] * acc[ai][1][m][0], v1 = acc[ai][0][m][1] * acc[ai][1][m][1];
                    u32x4 w; w.x = cvt_pk_bf16(v0[0], v0[1]); w.y = cvt_pk_bf16(v0[2], v0[3]); w.z = cvt_pk_bf16(v1[0], v1[1]); w.w = cvt_pk_bf16(v1[2], v1[3]);
                    *(u32x4*)(rowp) = w; }
        }
    }
};
struct EpiMlIn {
    static constexpr bool PERM = true;
    bf16_t* Q; bf16_t* Kb; bf16_t* O;
    __device__ __forceinline__ void operator()(const f32x4 (&acc)[2][2][4][2], const Unit& u, int wr, int wc, int fr, int fq) const {
        const int row0 = u.pm * BM + wr * 64 + fr, cw = wc * 32 + 8 * fq;
        bf16_t* base; int ldc; int mode;
        if (u.pn < 2) { base = Q + u.pn * BM + cw; ldc = 512; mode = 0; }
        else if (u.pn < 4) { base = Kb + (u.pn - 2) * BM + cw; ldc = 512; mode = 1; }
        else { base = O + (u.pn - 4) * BM + cw; ldc = 1024; mode = 2; }
#pragma unroll
        for (int ai = 0; ai < 2; ++ai)
#pragma unroll
            for (int m = 0; m < 4; ++m) { bf16_t* rowp = base + (size_t)(row0 + ai * HALF + m * 16) * ldc;
#pragma unroll
                for (int bj = 0; bj < 2; ++bj) { f32x4 v0 = acc[ai][bj][m][0], v1 = acc[ai][bj][m][1];
                    { const float sc = mode == 0 ? 0.125f * W8_INV : W8_INV; v0 = v0 * sc; v1 = v1 * sc; }
                    if (mode == 2) {
#pragma unroll
                        for (int j = 0; j < 4; ++j) { v0[j] = sigmoidf_(v0[j]); v1[j] = sigmoidf_(v1[j]); } }
                    u32x4 w; w.x = cvt_pk_bf16(v0[0], v0[1]); w.y = cvt_pk_bf16(v0[2], v0[3]); w.z = cvt_pk_bf16(v1[0], v1[1]); w.w = cvt_pk_bf16(v1[2], v1[3]);
                    *(u32x4*)(rowp + bj * HALF) = w; } }
    }
};
struct EpiResid {
    static constexpr bool PERM = true;
    const float* src_c; const float* src_l;
    bf16_t* X; const float* g;
    __device__ __forceinline__ void operator()(const f32x4 (&acc)[2][2][4][2], const Unit& u, int wr, int wc, int fr, int fq) const {
        const bool isctx = u.pm < 8;
        const int b9 = isctx ? 8 : ((u.pm - 8) >> 4);
        const int col0 = u.pn * BM + wc * 32 + 8 * fq;
        const float* gp = g + (size_t)b9 * 6144 + col0;
        f32x4 gv[2][2];
#pragma unroll
        for (int bj = 0; bj < 2; ++bj)
#pragma unroll
            for (int n = 0; n < 2; ++n) gv[bj][n] = *(const f32x4*)(gp + bj * HALF + 4 * n) * W8_INV;
        bf16_t* xp = X + (size_t)u.pm * BM * D + col0;
        if (src_l != nullptr) {
            const float* sp = (isctx ? src_c + (size_t)u.pm * BM * D : src_l + (size_t)(u.pm - 8) * BM * D) + col0;
#pragma unroll
            for (int ai = 0; ai < 2; ++ai)
#pragma unroll
                for (int m = 0; m < 4; ++m) { const size_t off = (size_t)(wr * 64 + ai * HALF + m * 16 + fr) * D;
#pragma unroll
                    for (int bj = 0; bj < 2; ++bj) { const f32x4 x0 = *(const f32x4*)(sp + off + bj * HALF), x1 = *(const f32x4*)(sp + off + bj * HALF + 4);
                        const f32x4 v0 = x0 + gv[bj][0] * acc[ai][bj][m][0], v1 = x1 + gv[bj][1] * acc[ai][bj][m][1];
                        u32x4 w; w.x = cvt_pk_bf16(v0[0], v0[1]); w.y = cvt_pk_bf16(v0[2], v0[3]); w.z = cvt_pk_bf16(v1[0], v1[1]); w.w = cvt_pk_bf16(v1[2], v1[3]);
                        *(u32x4*)(xp + off + bj * HALF) = w; } }
        } else {
#pragma unroll
            for (int ai = 0; ai < 2; ++ai) {
                u32x4 xs[4][2];
#pragma unroll
                for (int m = 0; m < 4; ++m) { const size_t off = (size_t)(wr * 64 + ai * HALF + m * 16 + fr) * D;
#pragma unroll
                    for (int bj = 0; bj < 2; ++bj) xs[m][bj] = *(const u32x4*)(xp + off + bj * HALF); }
                asm volatile("" ::: "memory");
#pragma unroll
                for (int m = 0; m < 4; ++m) { const size_t off = (size_t)(wr * 64 + ai * HALF + m * 16 + fr) * D;
#pragma unroll
                    for (int bj = 0; bj < 2; ++bj) { const u32x4 xv = xs[m][bj]; const f32x4 a0 = acc[ai][bj][m][0], a1 = acc[ai][bj][m][1];
                        u32x4 w;
                        w.x = cvt_pk_bf16(bflo(xv.x) + gv[bj][0][0] * a0[0], bfhi(xv.x) + gv[bj][0][1] * a0[1]); w.y = cvt_pk_bf16(bflo(xv.y) + gv[bj][0][2] * a0[2], bfhi(xv.y) + gv[bj][0][3] * a0[3]);
                        w.z = cvt_pk_bf16(bflo(xv.z) + gv[bj][1][0] * a1[0], bfhi(xv.z) + gv[bj][1][1] * a1[1]); w.w = cvt_pk_bf16(bflo(xv.w) + gv[bj][1][2] * a1[2], bfhi(xv.w) + gv[bj][1][3] * a1[3]);
                        *(u32x4*)(xp + off + bj * HALF) = w; } }
                asm volatile("" ::: "memory");
            }
        }
    }
};
struct EpiMoe1 {
    static constexpr bool PERM = true;
    unsigned char* ACT; const float* b1;
    static __device__ __forceinline__ f32x2 act2(f32x2 ag, f32x2 al, f32x2 bg, f32x2 bl1) {
        const f32x2 g = ag * W8_INV + bg, l1 = al * W8_INV + bl1;
        f32x2 a, b; a.x = fminf(g.x, 7.0f); a.y = fminf(g.y, 7.0f); b.x = __builtin_amdgcn_fmed3f(l1.x, -6.0f, 8.0f); b.y = __builtin_amdgcn_fmed3f(l1.y, -6.0f, 8.0f);
        const f32x2 t = a * (-1.702f * 1.44269504088896f);
        f32x2 e; e.x = __builtin_amdgcn_exp2f(t.x); e.y = __builtin_amdgcn_exp2f(t.y);
        const f32x2 d = e + 1.0f; f32x2 s; s.x = __builtin_amdgcn_rcpf(d.x); s.y = __builtin_amdgcn_rcpf(d.y);
        return (a * b) * s;
    }
    __device__ __forceinline__ void operator()(const f32x4 (&acc)[2][2][4][2], const Unit& u, int wr, int wc, int fr, int fq) const {
        const int row0 = u.pm * BM + wr * 64 + fr, ch0 = u.pn * HALF + wc * 32 + 8 * fq;
        const float* bp = b1 + (size_t)u.e * 2048 + ch0;
        const f32x4 bg0 = *(const f32x4*)(bp), bg1 = *(const f32x4*)(bp + 4), bl0 = *(const f32x4*)(bp + 1024) + 1.0f, bl1 = *(const f32x4*)(bp + 1028) + 1.0f;
#pragma unroll
        for (int ai = 0; ai < 2; ++ai)
#pragma unroll
            for (int m = 0; m < 4; ++m) { unsigned char* rowp = ACT + (size_t)(row0 + ai * HALF + m * 16) * D + ch0;
                const f32x4 g0 = acc[ai][0][m][0], g1 = acc[ai][0][m][1], l0 = acc[ai][1][m][0], l1 = acc[ai][1][m][1];
                const f32x2 r0 = act2((f32x2){g0[0], g0[1]}, (f32x2){l0[0], l0[1]}, (f32x2){bg0[0], bg0[1]}, (f32x2){bl0[0], bl0[1]});
                const f32x2 r1 = act2((f32x2){g0[2], g0[3]}, (f32x2){l0[2], l0[3]}, (f32x2){bg0[2], bg0[3]}, (f32x2){bl0[2], bl0[3]});
                const f32x2 r2 = act2((f32x2){g1[0], g1[1]}, (f32x2){l1[0], l1[1]}, (f32x2){bg1[0], bg1[1]}, (f32x2){bl1[0], bl1[1]});
                const f32x2 r3 = act2((f32x2){g1[2], g1[3]}, (f32x2){l1[2], l1[3]}, (f32x2){bg1[2], bg1[3]}, (f32x2){bl1[2], bl1[3]});
                u32x2 w; w.x = pk_fp8x4(r0.x, r0.y, r1.x, r1.y); w.y = pk_fp8x4(r2.x, r2.y, r3.x, r3.y);
                *(u32x2*)(rowp) = w; }
    }
};
struct EpiMoe2 {
    static constexpr bool PERM = true;
    unsigned char* Y; const float* b2;
    __device__ __forceinline__ void operator()(const f32x4 (&acc)[2][2][4][2], const Unit& u, int wr, int wc, int fr, int fq) const {
        const int row0 = u.pm * BM + wr * 64 + fr, col0 = u.pn * BM + wc * 32 + 8 * fq;
        const float* bp = b2 + (size_t)u.e * 1024 + col0;
        f32x4 bv[2][2];
#pragma unroll
        for (int bj = 0; bj < 2; ++bj)
#pragma unroll
            for (int n = 0; n < 2; ++n) bv[bj][n] = *(const f32x4*)(bp + bj * HALF + 4 * n);
#pragma unroll
        for (int ai = 0; ai < 2; ++ai)
#pragma unroll
            for (int m = 0; m < 4; ++m) { unsigned char* rowp = Y + (size_t)(row0 + ai * HALF + m * 16) * D + col0;
#pragma unroll
                for (int bj = 0; bj < 2; ++bj) { const f32x4 v0 = acc[ai][bj][m][0] * W8_INV + bv[bj][0], v1 = acc[ai][bj][m][1] * W8_INV + bv[bj][1];
                    f32x4 c0, c1;
#pragma unroll
                    for (int j = 0; j < 4; ++j) { c0[j] = __builtin_amdgcn_fmed3f(v0[j], -448.f, 448.f); c1[j] = __builtin_amdgcn_fmed3f(v1[j], -448.f, 448.f); }
                    u32x2 w; w.x = pk_fp8x4(c0[0], c0[1], c0[2], c0[3]); w.y = pk_fp8x4(c1[0], c1[1], c1[2], c1[3]);
                    *(u32x2*)(rowp + bj * HALF) = w; } }
    }
};

template <class Epi, class Sched, bool GATHER, bool FP8 = false>
__device__ __forceinline__ void gemm_phase(LAS unsigned char* lds, const Sched& S, const Epi& E, const int tid) {
    const int wid = __builtin_amdgcn_readfirstlane(tid >> 6), lane = tid & 63, wr = wid >> 2, wc = wid & 3, fr = lane & 15, fq = lane >> 4;
    const int K = S.K, nt = K / BK;
    unsigned voffA[2], voffB[2]; int Rrow[2]; unsigned coffA[2];
#pragma unroll
    for (int i = 0; i < 2; ++i) { int R, C; stage_rc(tid * 16 + i * 8192, R, C); const int Rb = Epi::PERM ? ((R & ~31) + perm32(R & 31)) : R;
        voffA[i] = (unsigned)(R * K + C) * 2u; voffB[i] = (unsigned)(Rb * K + C) * 2u; Rrow[i] = R; coffA[i] = (unsigned)C * 2u; }
    const size_t kstep = (size_t)(BK * 2);
    const size_t hstep = (size_t)HALF * K * 2;
    const unsigned ldsw = (unsigned)wid * 1024u;
    const int aoff = lds_byte(wr * 64 + fr, fq * 8), boff = lds_byte(wc * 32 + fr, fq * 8);
#define PG8_SA(b, h) (((b) * 2 + (h)) * HTB)
#define PG8_SB(b, h) ((4 + (b) * 2 + (h)) * HTB)
#define PG8_STAGE(bufoff, gbase, voff) do { _Pragma("unroll") for (int _i = 0; _i < 2; ++_i) \
        __builtin_amdgcn_global_load_lds((const unsigned*)((const char*)(gbase) + (size_t)(voff)[_i]), (LAS unsigned*)(lds + (bufoff) + ldsw + _i * 8192), 16, 0, 0); } while (0)
#define PG8_STAGE_G(bufoff, offs, kb) do { _Pragma("unroll") for (int _i = 0; _i < 2; ++_i) \
        __builtin_amdgcn_global_load_lds((const unsigned*)(gA + (size_t)((offs)[_i] + (unsigned)(kb))), (LAS unsigned*)(lds + (bufoff) + ldsw + _i * 8192), 16, 0, 0); } while (0)
#define PG8_LDA(dst, b, h) do { _Pragma("unroll") for (int m = 0; m < 4; ++m) { const u32x4 lo_ = *(const LAS u32x4*)(lds + PG8_SA(b, h) + aoff + m * 2048), hi_ = *(const LAS u32x4*)(lds + PG8_SA(b, h) + aoff + m * 2048 + 1024); \
        dst[m] = (v8i){(int)lo_.x, (int)lo_.y, (int)lo_.z, (int)lo_.w, (int)hi_.x, (int)hi_.y, (int)hi_.z, (int)hi_.w}; } } while (0)
#define PG8_LDB(dst, b, h) do { _Pragma("unroll") for (int n = 0; n < 2; ++n) { const u32x4 lo_ = *(const LAS u32x4*)(lds + PG8_SB(b, h) + boff + n * 2048), hi_ = *(const LAS u32x4*)(lds + PG8_SB(b, h) + boff + n * 2048 + 1024); \
        dst[n] = (v8i){(int)lo_.x, (int)lo_.y, (int)lo_.z, (int)lo_.w, (int)hi_.x, (int)hi_.y, (int)hi_.z, (int)hi_.w}; } } while (0)
#define PG8_MMA(ai, bj, At, Bt) do { __builtin_amdgcn_s_setprio(1); _Pragma("unroll") for (int m = 0; m < 4; ++m) _Pragma("unroll") for (int n = 0; n < 2; ++n) { \
        if constexpr (FP8) acc[ai][bj][m][n] = __builtin_amdgcn_mfma_scale_f32_16x16x128_f8f6f4(Bt[n], At[m], acc[ai][bj][m][n], 0, 0, 0, 0x7f7f7f7f, 0, 0x7f7f7f7f); \
        else { acc[ai][bj][m][n] = __builtin_amdgcn_mfma_f32_16x16x32_bf16(half8(Bt[n], 0), half8(At[m], 0), acc[ai][bj][m][n], 0, 0, 0); \
               acc[ai][bj][m][n] = __builtin_amdgcn_mfma_f32_16x16x32_bf16(half8(Bt[n], 1), half8(At[m], 1), acc[ai][bj][m][n], 0, 0, 0); } } __builtin_amdgcn_s_setprio(0); } while (0)
#define PG8_WAIT_V(n) asm volatile("s_waitcnt vmcnt(" #n ")" ::: "memory")
#define PG8_WAIT_L(n) asm volatile("s_waitcnt lgkmcnt(" #n ")" ::: "memory")
#define PG8_BAR __builtin_amdgcn_s_barrier()
#define PG8_SCHED __builtin_amdgcn_sched_barrier(0)
    Unit cur, nxt; int ui = 0;
    if (!S.next(0, cur)) return;
    f32x4 acc[2][2][4][2];
#pragma unroll
    for (int a = 0; a < 2; ++a)
#pragma unroll
        for (int b = 0; b < 2; ++b)
#pragma unroll
            for (int m = 0; m < 4; ++m)
#pragma unroll
                for (int n = 0; n < 2; ++n) acc[a][b][m][n] = (f32x4){0.f, 0.f, 0.f, 0.f};
    typename FragSel<FP8>::A At[4]; typename FragSel<FP8>::A B0[2], B1[2];
    const char* cA = GATHER ? nullptr : S.a_base(cur); const char* cB = S.b_base(cur);
    const char* gA = S.A;
    unsigned selA[2][2], cur1[2], nxtT[2][2];
    if constexpr (GATHER) { S.tok_off(cur, Rrow, coffA, selA); cur1[0] = selA[1][0]; cur1[1] = selA[1][1]; }
    PG8_STAGE(PG8_SB(0, 0), cB, voffB); PG8_STAGE(PG8_SB(0, 1), cB + hstep, voffB);
    if constexpr (GATHER) { PG8_STAGE_G(PG8_SA(0, 0), selA[0], 0); PG8_STAGE_G(PG8_SA(0, 1), selA[1], 0); }
    else { PG8_STAGE(PG8_SA(0, 0), cA, voffA); PG8_STAGE(PG8_SA(0, 1), cA + hstep, voffA); }
    if (wr == 1) PG8_BAR;
    PG8_WAIT_V(2); PG8_BAR;
    PG8_STAGE(PG8_SB(1, 0), cB + kstep, voffB);
    if constexpr (GATHER) PG8_STAGE_G(PG8_SA(1, 0), selA[0], kstep); else PG8_STAGE(PG8_SA(1, 0), cA + kstep, voffA);
    PG8_STAGE(PG8_SB(1, 1), cB + hstep + kstep, voffB);
    PG8_WAIT_V(6); PG8_BAR;
    for (;;) {
        const bool has_next = S.next(ui + 1, nxt);
        const char* nA = (!GATHER && has_next) ? S.a_base(nxt) : cA; const char* nB = has_next ? S.b_base(nxt) : cB;
        if constexpr (GATHER) { if (has_next) S.tok_off(nxt, Rrow, coffA, nxtT); }
        for (int t = 0; t < nt; t += 2) {
            const bool last = (t == nt - 2);
            const char* a1 = GATHER ? nullptr : cA + (size_t)(t + 1) * kstep;
            const char* a2 = GATHER ? nullptr : (last ? nA : cA + (size_t)(t + 2) * kstep); const char* b2 = last ? nB : cB + (size_t)(t + 2) * kstep;
            const char* a3 = GATHER ? nullptr : a2 + kstep; const char* b3 = b2 + kstep;
            const unsigned k1 = (unsigned)((t + 1) * kstep), k2 = last ? 0u : (unsigned)((t + 2) * kstep), k3 = k2 + (unsigned)kstep;
            PG8_LDB(B0, 0, 0); PG8_LDB(B1, 0, 1); PG8_SCHED; PG8_LDA(At, 0, 0);
            if constexpr (GATHER) PG8_STAGE_G(PG8_SA(1, 1), cur1, k1); else PG8_STAGE(PG8_SA(1, 1), a1 + hstep, voffA);
            if constexpr (GATHER) { if (last && has_next) {
#pragma unroll
                for (int h = 0; h < 2; ++h)
#pragma unroll
                    for (int i = 0; i < 2; ++i) selA[h][i] = nxtT[h][i]; } }
            PG8_WAIT_V(8); PG8_WAIT_L(0); PG8_BAR; PG8_MMA(0, 0, At, B0); PG8_MMA(0, 1, At, B1); PG8_BAR; PG8_SCHED;
            PG8_LDA(At, 0, 1); PG8_STAGE(PG8_SB(0, 0), b2, voffB); PG8_STAGE(PG8_SB(0, 1), b2 + hstep, voffB);
            if constexpr (GATHER) PG8_STAGE_G(PG8_SA(0, 0), selA[0], k2); else PG8_STAGE(PG8_SA(0, 0), a2, voffA);
            PG8_WAIT_V(8); PG8_WAIT_L(0); PG8_BAR; PG8_MMA(1, 0, At, B0); PG8_MMA(1, 1, At, B1); PG8_BAR; PG8_SCHED;
            PG8_LDB(B0, 1, 0); PG8_LDB(B1, 1, 1); PG8_SCHED; PG8_LDA(At, 1, 0);
            if constexpr (GATHER) PG8_STAGE_G(PG8_SA(0, 1), selA[1], k2); else PG8_STAGE(PG8_SA(0, 1), a2 + hstep, voffA);
            PG8_WAIT_V(8); PG8_WAIT_L(0); PG8_BAR; PG8_MMA(0, 0, At, B0); PG8_MMA(0, 1, At, B1); PG8_BAR; PG8_SCHED;
            PG8_LDA(At, 1, 1); PG8_STAGE(PG8_SB(1, 0), b3, voffB); PG8_STAGE(PG8_SB(1, 1), b3 + hstep, voffB);
            if constexpr (GATHER) PG8_STAGE_G(PG8_SA(1, 0), selA[0], k3); else PG8_STAGE(PG8_SA(1, 0), a3, voffA);
            PG8_WAIT_V(8); PG8_WAIT_L(0); PG8_BAR; PG8_MMA(1, 0, At, B0); PG8_MMA(1, 1, At, B1); PG8_BAR; PG8_SCHED;
        }
        if (wr == 0) PG8_BAR;
        { int fr_ = fr, fq_ = fq; asm volatile("" : "+v"(fr_), "+v"(fq_));
          E(acc, cur, wr, wc, fr_, fq_); }
        if (!has_next) break;
#pragma unroll
        for (int a = 0; a < 2; ++a)
#pragma unroll
            for (int b = 0; b < 2; ++b)
#pragma unroll
                for (int m = 0; m < 4; ++m)
#pragma unroll
                    for (int n = 0; n < 2; ++n) acc[a][b][m][n] = (f32x4){0.f, 0.f, 0.f, 0.f};
        cur = nxt; cA = nA; cB = nB; ++ui;
        if constexpr (GATHER) { cur1[0] = selA[1][0]; cur1[1] = selA[1][1]; }
        if (wr == 1) PG8_BAR;
    }
    PG8_WAIT_V(0);
    PG8_BAR;
#undef PG8_SA
#undef PG8_SB
#undef PG8_STAGE
#undef PG8_STAGE_G
#undef PG8_LDA
#undef PG8_LDB
#undef PG8_MMA
#undef PG8_WAIT_V
#undef PG8_WAIT_L
#undef PG8_BAR
#undef PG8_SCHED
}
}

#define XB_TMO      128
#define XB_XCNT(j)  (256  + 64 * (j))
#define XB_XSUB(j)  (1280 + 64 * (j))
#define XB_XGEN(j)  (2304 + 64 * (j))
#define XB_TOP      3328
#define XB_TOPGEN   3392
#define XCD_BAR_WORDS 3456
#define XB_SPIN_CAP (1u << 18)
__device__ __forceinline__ unsigned xb_ld(unsigned* p)              { return __hip_atomic_load(p, __ATOMIC_RELAXED, __HIP_MEMORY_SCOPE_AGENT); }
__device__ __forceinline__ unsigned xb_add(unsigned* p, unsigned v) { return __hip_atomic_fetch_add(p, v, __ATOMIC_RELAXED, __HIP_MEMORY_SCOPE_AGENT); }
__device__ __forceinline__ unsigned xb_xcc_id() { return (unsigned)__builtin_amdgcn_s_getreg((3 << 11) | 20) & 0xFu; }
#define XB_SPIN(cond, bar) do { unsigned _sp = 0; while (cond) { __builtin_amdgcn_s_sleep(1); \
    if ((++_sp & 255u) == 0u) { if (xb_ld(&(bar)[XB_TMO])) break; if (_sp > XB_SPIN_CAP) { atomicAdd(&(bar)[XB_TMO], 1u); break; } } } } while (0)
struct XcdBarrier { unsigned* bar; unsigned x; volatile LAS unsigned* st; };
__device__ __forceinline__ XcdBarrier xcd_barrier_post(unsigned* bar, volatile LAS unsigned* st) {
    XcdBarrier b; b.bar = bar; b.x = xb_xcc_id(); b.st = st;
    if (threadIdx.x == 0) (void)xb_add(&bar[XB_XCNT(b.x)], 1u);
    return b;
}
__device__ __forceinline__ void xcd_barrier_complete(unsigned* bar, unsigned x, unsigned& nloc, unsigned& nx) {
    const unsigned G = gridDim.x * gridDim.y * gridDim.z;
    unsigned sum, cnt, mine, sp = 0u;
    for (;;) {
        sum = 0u; cnt = 0u; mine = 0u;
#pragma unroll
        for (unsigned j = 0; j < 16; ++j) { const unsigned c = xb_ld(&bar[XB_XCNT(j)]); sum += c; cnt += (c > 0u) ? 1u : 0u; mine = (j == x) ? c : mine; }
        if (sum == G) break;
        __builtin_amdgcn_s_sleep(1);
        if ((++sp & 255u) == 0u) { if (xb_ld(&bar[XB_TMO])) break; if (sp > XB_SPIN_CAP) { atomicAdd(&bar[XB_TMO], 1u); break; } }
    }
    nloc = mine > 0u ? mine : 1u; nx = cnt > 0u ? cnt : 1u;
}
__device__ __forceinline__ void xcd_barrier(const XcdBarrier& b) {
    asm volatile("s_waitcnt vmcnt(0)" ::: "memory");
    __syncthreads();
    if (threadIdx.x == 0) {
        unsigned* bar = b.bar;
        __builtin_amdgcn_s_waitcnt(0);
        unsigned nloc = b.st[0], nx = b.st[1];
        if (nloc == 0u) { xcd_barrier_complete(bar, b.x, nloc, nx); b.st[0] = nloc; b.st[1] = nx; }
        const unsigned old = xb_add(&bar[XB_XSUB(b.x)], 1u);
        const unsigned gen = old / nloc;
        if (old + 1u == (gen + 1u) * nloc) {
            __builtin_amdgcn_fence(__ATOMIC_RELEASE, "agent");
            asm volatile("s_waitcnt vmcnt(0)" ::: "memory");
            const unsigned og = xb_add(&bar[XB_TOP], 1u);
            const unsigned tg = og / nx;
            if (og + 1u == (tg + 1u) * nx) xb_add(&bar[XB_TOPGEN], 1u);
            else XB_SPIN(xb_ld(&bar[XB_TOPGEN]) == tg, bar);
            __builtin_amdgcn_fence(__ATOMIC_ACQUIRE, "agent");
            xb_add(&bar[XB_XGEN(b.x)], 1u);
            asm volatile("s_waitcnt vmcnt(0)" ::: "memory");
        } else {
            XB_SPIN(xb_ld(&bar[XB_XGEN(b.x)]) == gen, bar);
            __builtin_amdgcn_fence(__ATOMIC_ACQUIRE, "agent");
            asm volatile("s_waitcnt vmcnt(0)" ::: "memory");
        }
    }
    __syncthreads();
}

constexpr size_t MiB = 1u << 20;
constexpr size_t WS_CTL = 0, CTL_ZERO_BYTES = 128 * 1024;
constexpr int CW_BAR = 4096, CW_CNT = 16384;
constexpr size_t WS_MOD   = 1 * MiB;
constexpr size_t WS_ROPE  = 2 * MiB;
constexpr size_t WS_XC    = 3 * MiB;
constexpr size_t WS_XB    = 1700 * MiB;
constexpr size_t WS_WCIN  = 11 * MiB;
constexpr size_t WS_WCOUT = 23 * MiB;
constexpr size_t WS_WMLN  = 27 * MiB;
constexpr size_t WS_WMLS  = 31 * MiB;
constexpr size_t WS_WMLO  = 34 * MiB;
constexpr size_t WS_WMLG  = 36 * MiB;
constexpr size_t WS_WDN   = 37 * MiB;
constexpr size_t WS_WUQ   = 39 * MiB;
constexpr size_t WS_WKN   = 41 * MiB;
constexpr size_t WS_WV    = 42 * MiB;
constexpr size_t WS_WMO   = 43 * MiB;
constexpr size_t WS_WR    = 45 * MiB;
constexpr size_t WS_TOPE  = 46 * MiB;
constexpr size_t WS_TPOS  = 47 * MiB;
constexpr size_t WS_GATE  = 48 * MiB;
constexpr size_t WS_LIST  = 49 * MiB;
constexpr size_t WS_G32   = 54 * MiB;
constexpr size_t WS_SCU   = 59 * MiB;
constexpr size_t WS_SCMU  = 62 * MiB;
static_assert(true, "");
constexpr size_t WS_SCB   = 65 * MiB;
constexpr size_t WS_CHM   = 68 * MiB;
constexpr size_t WS_NST   = 69 * MiB;
constexpr size_t WS_W1    = 72 * MiB;
constexpr size_t WS_W2    = 584 * MiB;
constexpr size_t WS_H     = 840 * MiB;
constexpr size_t WS_A0    = 908 * MiB;
constexpr size_t WS_A1    = 1012 * MiB;
constexpr size_t WS_A2    = 1116 * MiB;
constexpr size_t WS_A3    = 1220 * MiB;
constexpr size_t WS_A4    = 1292 * MiB;
constexpr size_t WS_A5    = 1364 * MiB;
constexpr size_t WS_A6    = 1504 * MiB;
constexpr size_t WS_XP    = 1624 * MiB;
constexpr size_t WS_ACT   = 1912 * MiB;
constexpr size_t WS_Y     = 2200 * MiB;
constexpr size_t WS_END   = 2488 * MiB;

constexpr int RING_BYTES = 131072, MISC_OFF = RING_BYTES, LDS_BYTES = 147456;
constexpr int MI_PEXP = 1152;
constexpr int MI_BAR = 0, MI_PPRE = 16, MI_HIST = 64, MI_BASE = 96, MI_SCR = 128, MI_CNT = 960, MI_INP = 1024;

struct Args { const float* in[31]; float* out; unsigned char* ws; int ph_lo, ph_hi; };

struct Frame {
    LAS unsigned char* lds; volatile LAS int* MISC; unsigned* ctl; unsigned char* ws;
    int tid, lane, wave, G, vcu;
    float* out;
};
__device__ __forceinline__ const float* inp(const Frame& F, int i) {
    const unsigned lo = __builtin_amdgcn_readfirstlane((unsigned)F.MISC[MI_INP + 2 * i]), hi = __builtin_amdgcn_readfirstlane((unsigned)F.MISC[MI_INP + 2 * i + 1]);
    return (const float*)(__attribute__((address_space(1))) const float*)(((unsigned long long)hi << 32) | lo);
}
#define IN_X 0
#define IN_C 1
#define IN_CTX 2
#define IN_CCTX 3
#define IN_NORM_MIX 4
#define IN_NORM_FFN 5
#define IN_W_MOD 6
#define IN_B_MOD 7
#define IN_CONV_W_IN 8
#define IN_CONV_W 9
#define IN_CONV_W_OUT 10
#define IN_ML_W_IN 11
#define IN_ML_B_GATE 12
#define IN_ML_NORM 13
#define IN_ML_W_OUT 14
#define IN_MLA_W_IN 15
#define IN_MLA_Q_NORM 16
#define IN_MLA_KV_NORM 17
#define IN_MLA_W_UQ 18
#define IN_MLA_W_UKV 19
#define IN_MLA_QN_NOPE 20
#define IN_MLA_QN_ROPE 21
#define IN_MLA_KN_NOPE 22
#define IN_MLA_KN_ROPE 23
#define IN_MLA_W_OUT 24
#define IN_MOE_W_ROUTER 25
#define IN_MOE_B_ROUTER 26
#define IN_MOE_W1 27
#define IN_MOE_B1 28
#define IN_MOE_W2 29
#define IN_MOE_B2 30

#define WSP(T, off) ((T*)(F.ws + (off)))

constexpr int TR_STR = 136, TR_BYTES = 64 * TR_STR;
__device__ __forceinline__ void transpose_item(const float* W, int ldn, int k0, int n0, int nvalid, bf16_t* WT, int Kd, int drow0, LAS unsigned char* scr, int lane) {
    const float* wp = W + (size_t)k0 * ldn + n0 + (lane < nvalid ? lane : 0);
    float v[64];
#pragma unroll
    for (int kk = 0; kk < 64; ++kk) v[kk] = __builtin_nontemporal_load(wp + (size_t)kk * ldn);
#pragma unroll
    for (int kp = 0; kp < 32; ++kp) *(LAS unsigned*)(scr + lane * TR_STR + kp * 4) = cvt_pk_bf16(v[2 * kp], v[2 * kp + 1]);
    asm volatile("s_waitcnt lgkmcnt(0)" ::: "memory");
#pragma unroll
    for (int j = 0; j < 8; ++j) { const int q = lane + 64 * j, n = q >> 3, c = q & 7; const LAS unsigned char* p = scr + n * TR_STR + c * 16;
        const u32x2 lo = *(const LAS u32x2*)p, hi = *(const LAS u32x2*)(p + 8);
        if (n < nvalid) *(u32x4*)(WT + (size_t)(drow0 + n) * Kd + k0 + 8 * c) = (u32x4){lo.x, lo.y, hi.x, hi.y}; }
    asm volatile("s_waitcnt lgkmcnt(0)" ::: "memory");
}
constexpr int TR8_STR = 136;
__device__ __forceinline__ void transpose_item_f8(const float* W, int ldn, int k0, int n0, unsigned char* WT, int Kd, int drow0, LAS unsigned char* scr, int lane) {
#pragma unroll
    for (int half = 0; half < 2; ++half) {
        const float* wp = W + (size_t)(k0 + 64 * half) * ldn + n0 + lane;
        float v[64];
#pragma unroll
        for (int kk = 0; kk < 64; ++kk) v[kk] = __builtin_nontemporal_load(wp + (size_t)kk * ldn);
#pragma unroll
        for (int kq = 0; kq < 16; ++kq) *(LAS unsigned*)(scr + lane * TR8_STR + half * 64 + kq * 4) = pk_fp8x4(v[4 * kq] * W8_SCALE, v[4 * kq + 1] * W8_SCALE, v[4 * kq + 2] * W8_SCALE, v[4 * kq + 3] * W8_SCALE);
    }
    asm volatile("s_waitcnt lgkmcnt(0)" ::: "memory");
#pragma unroll
    for (int j = 0; j < 8; ++j) { const int q = lane + 64 * j, n = q >> 3, c = q & 7; const LAS unsigned char* p = scr + n * TR8_STR + c * 16;
        const u32x2 lo = *(const LAS u32x2*)p, hi = *(const LAS u32x2*)(p + 8);
        *(u32x4*)(WT + (size_t)(drow0 + n) * Kd + k0 + 16 * c) = (u32x4){lo.x, lo.y, hi.x, hi.y}; }
    asm volatile("s_waitcnt lgkmcnt(0)" ::: "memory");
}
__device__ __forceinline__ int map_pair128(int n0, int half) { return (n0 >> 7) * 256 + half * 128 + (n0 & 127); }

__device__ __forceinline__ void phase_prologue(Frame& F) {
    LAS unsigned char* scr = F.lds + F.wave * TR_BYTES;
    const int gw = F.vcu * 8 + F.wave, NGW = F.G * 8;
    constexpr int I_CIN = 16 * 48, I_COUT = 8 * 16, I_MLIN = 8 * 48 + 16, I_MLK2 = 8 * 8, I_MLO = 8 * 16, I_DN = 16 * 11, I_UQ = 6 * 24, I_UKV = 4 * 32, I_MO = 8 * 16, I_R = 16 * 1, I_W1 = 8 * 32, I_W2 = 8 * 16;
    constexpr int N_SMALL = 2 * I_CIN + 2 * I_COUT + I_MLIN + I_MLK2 + I_MLO + I_DN + I_UQ + I_UKV + I_MO + 4 * I_R;
    constexpr int N_W1 = 128 * I_W1, N_W2 = 128 * I_W2;
    constexpr int NITEMS = N_SMALL + N_W1 + N_W2;
    for (int it = gw; it < NITEMS; it += NGW) {
        int r = NITEMS - 1 - it;
        if (r >= N_SMALL) {
            r -= N_SMALL;
            if (r < N_W1) { const int mat = r / I_W1, q = r % I_W1, kb = q / 32, nb = q % 32, n0 = nb * 64;
                const int drow = n0 < 1024 ? map_pair128(n0, 0) : map_pair128(n0 - 1024, 1);
                transpose_item_f8(inp(F, IN_MOE_W1) + (size_t)mat * 1024 * 2048, 2048, kb * 128, n0, WSP(unsigned char, WS_W1) + (size_t)mat * 2048 * 1024, 1024, drow, scr, F.lane); continue; }
            r -= N_W1;
            { const int mat = r / I_W2, q = r % I_W2, kb = q / 16, nb = q % 16;
                transpose_item_f8(inp(F, IN_MOE_W2) + (size_t)mat * 1024 * 1024, 1024, kb * 128, nb * 64, WSP(unsigned char, WS_W2) + (size_t)mat * 1024 * 1024, 1024, nb * 64, scr, F.lane); continue; }
        }
        if (r < 2 * I_CIN) { const int mat = r / I_CIN, q = r % I_CIN, kb = q / 48, nb = q % 48, n0 = nb * 64;
            const int drow = n0 < 1024 ? n0 : (n0 < 2048 ? 1024 + map_pair128(n0 - 1024, 0) : 1024 + map_pair128(n0 - 2048, 1));
            transpose_item(inp(F, IN_CONV_W_IN) + (size_t)mat * 1024 * 3072, 3072, kb * 64, n0, 64, WSP(bf16_t, WS_WCIN) + (size_t)mat * 3072 * 1024, 1024, drow, scr, F.lane); continue; }
        r -= 2 * I_CIN;
        if (r < 2 * I_COUT) { const int mat = r / I_COUT, q = r % I_COUT, kb = q / 16, nb = q % 16;
            transpose_item_f8(inp(F, IN_CONV_W_OUT) + (size_t)mat * 1024 * 1024, 1024, kb * 128, nb * 64, WSP(unsigned char, WS_WCOUT) + (size_t)mat * 1024 * 1024, 1024, nb * 64, scr, F.lane); continue; }
        r -= 2 * I_COUT;
        if (r < I_MLIN) {
            if (r < 8 * 48) { const int kb = r / 48, nb = r % 48, n0 = nb * 64;
                unsigned char* dst; int drow;
                if (n0 < 1024) { dst = WSP(unsigned char, WS_WMLN); drow = n0; }
                else if (n0 < 2048) { dst = WSP(unsigned char, WS_WMLS); drow = 512 + (n0 - 1024); }
                else { dst = WSP(unsigned char, WS_WMLN); drow = 1024 + (n0 - 2048); }
                transpose_item_f8(inp(F, IN_ML_W_IN), 3104, kb * 128, n0, dst, 1024, drow, scr, F.lane); }
            else transpose_item(inp(F, IN_ML_W_IN), 3104, (r - 8 * 48) * 64, 3072, 32, WSP(bf16_t, WS_WMLG), 1024, 0, scr, F.lane);
            continue; }
        r -= I_MLIN;
        if (r < I_MLK2) { const int kb = r / 8, nb = r % 8, n0 = 512 + nb * 64;
            transpose_item_f8(inp(F, IN_ML_W_IN), 3104, kb * 128, n0, WSP(unsigned char, WS_WMLS), 1024, n0 - 512, scr, F.lane); continue; }
        r -= I_MLK2;
        if (r < I_MLO) { const int kb = r / 16, nb = r % 16;
            transpose_item_f8(inp(F, IN_ML_W_OUT), 1024, kb * 128, nb * 64, WSP(unsigned char, WS_WMLO), 1024, nb * 64, scr, F.lane); continue; }
        r -= I_MLO;
        if (r < I_DN) { const int kb = r / 11, nb = r % 11;
            transpose_item(inp(F, IN_MLA_W_IN), 704, kb * 64, nb * 64, 64, WSP(bf16_t, WS_WDN), 1024, nb * 64, scr, F.lane); continue; }
        r -= I_DN;
        if (r < I_UQ) { const int kb = r / 24, nb = r % 24;
            transpose_item(inp(F, IN_MLA_W_UQ), 1536, kb * 64, nb * 64, 64, WSP(bf16_t, WS_WUQ), 384, nb * 64, scr, F.lane); continue; }
        r -= I_UQ;
        if (r < I_UKV) { const int kb = r / 32, nb = r % 32, n0 = nb * 64, hd = n0 >> 8, within = n0 & 255;
            bf16_t* dst = within < 128 ? WSP(bf16_t, WS_WKN) : WSP(bf16_t, WS_WV);
            transpose_item(inp(F, IN_MLA_W_UKV), 2048, kb * 64, n0, 64, dst, 256, hd * 128 + (within & 127), scr, F.lane); continue; }
        r -= I_UKV;
        if (r < I_MO) { const int kb = r / 16, nb = r % 16;
            transpose_item_f8(inp(F, IN_MLA_W_OUT), 1024, kb * 128, nb * 64, WSP(unsigned char, WS_WMO), 1024, nb * 64, scr, F.lane); continue; }
        r -= I_MO;
        { const int mat = r / I_R, kb = r % I_R;
            transpose_item(inp(F, IN_MOE_W_ROUTER) + (size_t)mat * 1024 * 32, 32, kb * 64, 0, 32, WSP(bf16_t, WS_WR) + (size_t)mat * 32 * 1024, 1024, 0, scr, F.lane); }
    }
    { u32x4* z = (u32x4*)(WSP(bf16_t, WS_WDN) + (size_t)704 * 1024); const int n16 = 64 * 1024 * 2 / 16;
      for (int i = blockIdx.x * 512 + F.tid; i < n16; i += F.G * 512) z[i] = (u32x4){0u, 0u, 0u, 0u}; }
    if (blockIdx.x == 0) {
        float* rc = WSP(float, WS_ROPE); float* rs = rc + 1024;
        for (int i = F.tid; i < 1024; i += 512) { const int pos = i >> 4, f = i & 15;
            const float inv = exp2f(-(float)f * (13.287712379549449f / 16.0f));
            const float ang = (float)pos * inv; rc[i] = cosf(ang); rs[i] = sinf(ang); }
    }
    __syncthreads();
    {
        LAS float* sl = (LAS float*)(F.lds);
        LAS float* red = (LAS float*)(F.lds + 36864);
        for (int idx = F.tid; idx < 9 * 1024; idx += 512) { const int rr = idx >> 10, k = idx & 1023; const float cv = rr < 8 ? inp(F, IN_C)[rr * 1024 + k] : inp(F, IN_CCTX)[k]; sl[idx] = cv * sigmoidf_(cv); }
        __syncthreads();
        float* MOD = WSP(float, WS_MOD);
        for (int unit = blockIdx.x; unit < 4 * 96; unit += F.G) {
            const int l = unit / 96, n0 = (unit % 96) * 64, n = n0 + F.lane;
            float acc[9];
#pragma unroll
            for (int q = 0; q < 9; ++q) acc[q] = 0.f;
            const float* wp = inp(F, IN_W_MOD) + ((size_t)l * 1024 + F.wave * 128) * 6144 + n;
#pragma unroll 16
            for (int kk = 0; kk < 128; ++kk) { const float wv = wp[(size_t)kk * 6144]; const int k = F.wave * 128 + kk;
#pragma unroll
                for (int q = 0; q < 9; ++q) acc[q] += sl[q * 1024 + k] * wv; }
#pragma unroll
            for (int q = 0; q < 9; ++q) red[(F.wave * 9 + q) * 64 + F.lane] = acc[q];
            __syncthreads();
            for (int idx = F.tid; idx < 576; idx += 512) { const int q = idx >> 6, ln = idx & 63; float s = 0.f;
#pragma unroll
                for (int w = 0; w < 8; ++w) s += red[(w * 9 + q) * 64 + ln];
                MOD[((size_t)l * 9 + q) * 6144 + n0 + ln] = s + inp(F, IN_B_MOD)[l * 6144 + n0 + ln]; }
            __syncthreads();
        }
    }
}

__device__ __forceinline__ void moe_tables(Frame& F, int layer, bool panel_table = false) {
    if (F.wave == 0) {
        const int lane = F.lane; const unsigned* cnt = F.ctl + CW_CNT + layer * 64;
        const int c = (int)cnt[lane & (NEXP - 1)], np = lane < NEXP ? (c + 255) >> 8 : 0;
        int incl = np;
#pragma unroll
        for (int o = 1; o < NEXP; o <<= 1) { const int t = __builtin_amdgcn_ds_bpermute((lane - o) << 2, incl); if (lane >= o) incl += t; }
        if (lane < NEXP) { F.MISC[MI_PPRE + lane] = incl - np; F.MISC[MI_CNT + lane] = c; }
        if (lane == NEXP - 1) F.MISC[MI_PPRE + NEXP] = incl;
    }
    __syncthreads();
    if (panel_table) {
        const int np = F.MISC[MI_PPRE + NEXP];
        for (int p = F.tid; p < np; p += 512) { int e = 0;
#pragma unroll 8
            for (int k = 1; k < NEXP; ++k) e += (F.MISC[MI_PPRE + k] <= p) ? 1 : 0;
            F.MISC[MI_PEXP + p] = e; }
        __syncthreads();
    }
}

__device__ __forceinline__ float wave_sum_fast(float v, int lane) {
    v += __int_as_float(__builtin_amdgcn_update_dpp(0, __float_as_int(v), 0xB1, 0xF, 0xF, true));
    v += __int_as_float(__builtin_amdgcn_update_dpp(0, __float_as_int(v), 0x4E, 0xF, 0xF, true));
    v += __int_as_float(__builtin_amdgcn_update_dpp(0, __float_as_int(v), 0x141, 0xF, 0xF, true));
    v += __int_as_float(__builtin_amdgcn_update_dpp(0, __float_as_int(v), 0x140, 0xF, 0xF, true));
    v += shx(v, 16, lane); v += shx(v, 32, lane);
    return v;
}
#define PN_COL(jj) (8 * lane + 512 * ((jj) >> 1) + 4 * ((jj) & 1))
__device__ __forceinline__ void moe_y_load(const Frame& F, const unsigned char* Y, const int (&e4)[4], const int (&p4)[4], int lane, unsigned (&yv)[4][4]) {
#pragma unroll
    for (int k = 0; k < 4; ++k) { const unsigned char* yr = Y + ((size_t)F.MISC[MI_PPRE + e4[k]] * 256 + p4[k]) * D + 8 * lane;
#pragma unroll
        for (int j2 = 0; j2 < 2; ++j2) { const u32x2 t = *(const u32x2*)(yr + 512 * j2); yv[k][2 * j2] = t.x; yv[k][2 * j2 + 1] = t.y; } }
}
__device__ __forceinline__ void moe_y_sum(const unsigned (&yv)[4][4], const float (&g4)[4], f32x4 (&ys)[4]) {
#pragma unroll
    for (int j = 0; j < 4; ++j) { ys[j] = (f32x4){0.f, 0.f, 0.f, 0.f};
#pragma unroll
        for (int k = 0; k < 4; ++k) { const f32x2 lo = __builtin_amdgcn_cvt_pk_f32_fp8((int)yv[k][j], false), hi = __builtin_amdgcn_cvt_pk_f32_fp8((int)yv[k][j], true);
            ys[j][0] += g4[k] * lo.x; ys[j][1] += g4[k] * lo.y; ys[j][2] += g4[k] * hi.x; ys[j][3] += g4[k] * hi.y; } }
}
template <bool FIRST, bool COMBINE, int EXTRA>
__device__ __forceinline__ void phase_norm(Frame& F, int layer, int which, int row_lo, int row_hi) {
    const int lane = F.lane;
    const float* MOD = WSP(float, WS_MOD);
    bf16_t* XB = WSP(bf16_t, WS_XB);
    bf16_t* H = WSP(bf16_t, WS_H); unsigned char* H8 = WSP(unsigned char, WS_XP);
    int* TOPE = WSP(int, WS_TOPE); int* TPOS = WSP(int, WS_TPOS); float* GATE = WSP(float, WS_GATE);
    const unsigned char* Y = WSP(unsigned char, WS_Y);
    if (COMBINE) moe_tables(F, layer - 1);
    if (EXTRA != 0) {
        const bf16_t* W32g = (EXTRA == 1) ? WSP(bf16_t, WS_WR) + (size_t)layer * 32 * 1024 : WSP(bf16_t, WS_WMLG);
        u32x4 wv[8];
#pragma unroll
        for (int i = 0; i < 8; ++i) { const int pc = F.tid + 512 * i; wv[i] = *(const u32x4*)(W32g + (size_t)(pc >> 7) * 1024 + (pc & 127) * 8); }
#pragma unroll
        for (int i = 0; i < 8; ++i) { const int pc = F.tid + 512 * i; *(LAS u32x4*)(F.lds + (pc >> 7) * 2064 + (pc & 127) * 16) = wv[i]; }
        if (EXTRA == 1) { if (F.tid < 32) F.MISC[MI_HIST + F.tid] = 0; }
        __syncthreads();
    }
    const float* gain = inp(F, which ? IN_NORM_FFN : IN_NORM_MIX) + layer * 1024;
    const int gw = blockIdx.x * 8 + F.wave, NGW = F.G * 8;
    const int nrows = row_hi - row_lo, rpw = (nrows + NGW - 1) / NGW;
    const int r0 = row_lo + gw * rpw, r1 = (r0 + rpw < row_hi) ? r0 + rpw : row_hi;
    const int fr = lane & 15, fq = lane >> 4;
    constexpr int NR = COMBINE ? 2 : 4;
    f32x4 cA[4], cB[4], cG[4]; int cb = -1, cgb = -1;
#pragma unroll
    for (int j = 0; j < 4; ++j) { cA[j] = (f32x4){0.f, 0.f, 0.f, 0.f}; cB[j] = cA[j]; cG[j] = cA[j]; }
    int4 evn[NR], pvn[NR]; f32x4 gvn[NR];
    if (COMBINE) {
#pragma unroll
        for (int q = 0; q < NR; ++q) { const int row = r0 + q < r1 ? r0 + q : r0; evn[q] = *(const int4*)(TOPE + row * 4); pvn[q] = *(const int4*)(TPOS + row * 4); gvn[q] = *(const f32x4*)(GATE + row * 4); } }
    for (int rg = r0; rg < r1; rg += NR) {
        f32x4 v[NR][4]; int b9[NR]; bool act[NR];
#pragma unroll
        for (int q = 0; q < NR; ++q) {
            act[q] = rg + q < r1; const int row = act[q] ? rg + q : rg; const bool isctx = row < T_CTX;
            b9[q] = isctx ? 8 : ((row - T_CTX) >> 12);
            if (FIRST) { const float* xs = isctx ? inp(F, IN_CTX) + (size_t)row * D : inp(F, IN_X) + (size_t)(row - T_CTX) * D;
#pragma unroll
                for (int j = 0; j < 4; ++j) v[q][j] = *(const f32x4*)(xs + PN_COL(j));
            } else { const bf16_t* xs = XB + (size_t)row * D;
#pragma unroll
                for (int j2 = 0; j2 < 2; ++j2) { const u32x4 t = *(const u32x4*)(xs + 8 * lane + 512 * j2); v[q][2 * j2] = (f32x4){bflo(t.x), bfhi(t.x), bflo(t.y), bfhi(t.y)}; v[q][2 * j2 + 1] = (f32x4){bflo(t.z), bfhi(t.z), bflo(t.w), bfhi(t.w)}; } }
        }
        if (COMBINE) {
            unsigned yv[NR][4][4]; float g4[NR][4];
#pragma unroll
            for (int q = 0; q < NR; ++q) { int e4[4], p4[4];
                const int4 ev = evn[q], pv = pvn[q]; const f32x4 gv = gvn[q];
                e4[0] = __builtin_amdgcn_readfirstlane(ev.x); e4[1] = __builtin_amdgcn_readfirstlane(ev.y); e4[2] = __builtin_amdgcn_readfirstlane(ev.z); e4[3] = __builtin_amdgcn_readfirstlane(ev.w);
                p4[0] = __builtin_amdgcn_readfirstlane(pv.x); p4[1] = __builtin_amdgcn_readfirstlane(pv.y); p4[2] = __builtin_amdgcn_readfirstlane(pv.z); p4[3] = __builtin_amdgcn_readfirstlane(pv.w);
                g4[q][0] = gv[0]; g4[q][1] = gv[1]; g4[q][2] = gv[2]; g4[q][3] = gv[3];
                moe_y_load(F, Y, e4, p4, lane, yv[q]); }
#pragma unroll
            for (int q = 0; q < NR; ++q) { const int row = rg + NR + q < r1 ? rg + NR + q : rg; evn[q] = *(const int4*)(TOPE + row * 4); pvn[q] = *(const int4*)(TPOS + row * 4); gvn[q] = *(const f32x4*)(GATE + row * 4); }
#pragma unroll
            for (int q = 0; q < NR; ++q) { const int row = act[q] ? rg + q : rg; const bool isctx = row < T_CTX;
                f32x4 ys[4]; moe_y_sum(yv[q], g4[q], ys);
                if (b9[q] != cgb) { cgb = b9[q]; const float* gf = MOD + ((size_t)(layer - 1) * 9 + cgb) * 6144 + 5 * 1024;
#pragma unroll
                    for (int j = 0; j < 4; ++j) cG[j] = *(const f32x4*)(gf + PN_COL(j)); }
                bf16_t* xd = XB + (size_t)row * D;
#pragma unroll
                for (int j = 0; j < 4; ++j) v[q][j] = v[q][j] + cG[j] * ys[j];
#pragma unroll
                for (int j2 = 0; j2 < 2; ++j2) if (act[q]) { u32x4 o; o.x = cvt_pk_bf16(v[q][2 * j2][0], v[q][2 * j2][1]); o.y = cvt_pk_bf16(v[q][2 * j2][2], v[q][2 * j2][3]);
                    o.z = cvt_pk_bf16(v[q][2 * j2 + 1][0], v[q][2 * j2 + 1][1]); o.w = cvt_pk_bf16(v[q][2 * j2 + 1][2], v[q][2 * j2 + 1][3]); *(u32x4*)(xd + 8 * lane + 512 * j2) = o; } }
        }
#pragma unroll
        for (int q = 0; q < NR; ++q) {
            const int row = act[q] ? rg + q : rg;
            float ss = 0.f;
#pragma unroll
            for (int j = 0; j < 4; ++j) ss += (v[q][j][0] * v[q][j][0] + v[q][j][1] * v[q][j][1]) + (v[q][j][2] * v[q][j][2] + v[q][j][3] * v[q][j][3]);
            const float rstd = 1.0f / sqrtf(wave_sum_fast(ss, lane) * (1.0f / D) + RMS_EPS);
            if (b9[q] != cb) { cb = b9[q]; const float* mp = MOD + ((size_t)layer * 9 + cb) * 6144;
#pragma unroll
                for (int j = 0; j < 4; ++j) { const f32x4 g4v = *(const f32x4*)(gain + PN_COL(j));
                    const f32x4 sc = *(const f32x4*)(mp + (which ? 4 : 1) * 1024 + PN_COL(j)); cB[j] = *(const f32x4*)(mp + (which ? 3 : 0) * 1024 + PN_COL(j)); cA[j] = g4v * (sc + 1.0f); } }
#pragma unroll
            for (int j2 = 0; j2 < 2; ++j2) {
                const f32x4 h0 = (v[q][2 * j2] * rstd) * cA[2 * j2] + cB[2 * j2], h1 = (v[q][2 * j2 + 1] * rstd) * cA[2 * j2 + 1] + cB[2 * j2 + 1];
                u32x4 o; o.x = cvt_pk_bf16(h0[0], h0[1]); o.y = cvt_pk_bf16(h0[2], h0[3]); o.z = cvt_pk_bf16(h1[0], h1[1]); o.w = cvt_pk_bf16(h1[2], h1[3]);
                if (act[q]) *(u32x4*)(H + (size_t)row * D + 8 * lane + 512 * j2) = o;
                if (EXTRA != 0) { if (act[q]) { u32x2 o8;
                    o8.x = pk_fp8x4(__builtin_amdgcn_fmed3f(h0[0], -448.f, 448.f), __builtin_amdgcn_fmed3f(h0[1], -448.f, 448.f), __builtin_amdgcn_fmed3f(h0[2], -448.f, 448.f), __builtin_amdgcn_fmed3f(h0[3], -448.f, 448.f));
                    o8.y = pk_fp8x4(__builtin_amdgcn_fmed3f(h1[0], -448.f, 448.f), __builtin_amdgcn_fmed3f(h1[1], -448.f, 448.f), __builtin_amdgcn_fmed3f(h1[2], -448.f, 448.f), __builtin_amdgcn_fmed3f(h1[3], -448.f, 448.f));
                    *(u32x2*)(H8 + (size_t)row * D + 8 * lane + 512 * j2) = o8; } }
            }
        }
    }
    if (EXTRA != 0) {
        asm volatile("s_waitcnt vmcnt(0)" ::: "memory");
        for (int t0 = r0; t0 < r1; t0 += 16) {
            const int nval = (r1 - t0 < 16) ? r1 - t0 : 16;
            const int brow = t0 + (fr < nval ? fr : nval - 1);
            f32x4 a0 = (f32x4){0.f, 0.f, 0.f, 0.f}, a1 = a0;
            const bf16_t* hp = H + (size_t)brow * D + 8 * fq;
            const LAS unsigned char* w0p = F.lds + fr * 2064 + 16 * fq; const LAS unsigned char* w1p = w0p + 16 * 2064;
#pragma unroll 4
            for (int ks = 0; ks < 32; ++ks) {
                const bf16x8 hb = *(const bf16x8*)(hp + 32 * ks), w0 = *(const LAS bf16x8*)(w0p + 64 * ks), w1 = *(const LAS bf16x8*)(w1p + 64 * ks);
                a0 = MFMA16(w0, hb, a0); a1 = MFMA16(w1, hb, a1);
            }
            const int row = t0 + fr; const bool rv = fr < nval;
            if (EXTRA == 1) {
                const float* br = inp(F, IN_MOE_B_ROUTER) + layer * 32;
                float vals[8]; int idxs[8];
#pragma unroll
                for (int i = 0; i < 4; ++i) { idxs[i] = 4 * fq + i; vals[i] = a0[i] + br[4 * fq + i]; idxs[4 + i] = 16 + 4 * fq + i; vals[4 + i] = a1[i] + br[16 + 4 * fq + i]; }
                float tv[4]; int ti[4];
#pragma unroll
                for (int k = 0; k < 4; ++k) {
                    float bv = vals[0]; int bi = idxs[0];
#pragma unroll
                    for (int i = 1; i < 8; ++i) { const bool better = vals[i] > bv; bv = better ? vals[i] : bv; bi = better ? idxs[i] : bi; }
#pragma unroll
                    for (int o = 16; o <= 32; o <<= 1) { const float ov = shx(bv, o, lane); const int oi = shxi(bi, o, lane); const bool better = (ov > bv) || (ov == bv && oi < bi); bv = better ? ov : bv; bi = better ? oi : bi; }
                    tv[k] = bv; ti[k] = bi;
#pragma unroll
                    for (int i = 0; i < 8; ++i) vals[i] = (idxs[i] == bi) ? -3.0e38f : vals[i];
                }
                const float e1 = fast_exp(tv[1] - tv[0]), e2 = fast_exp(tv[2] - tv[0]), e3 = fast_exp(tv[3] - tv[0]);
                const float inv = 1.0f / (1.0f + e1 + e2 + e3);
                if (fq == 0 && rv) {
                    int rk[4];
#pragma unroll
                    for (int k = 0; k < 4; ++k) rk[k] = __hip_atomic_fetch_add((LAS int*)&F.MISC[MI_HIST + ti[k]], 1, __ATOMIC_RELAXED, __HIP_MEMORY_SCOPE_WORKGROUP);
                    *(int4*)(TOPE + row * 4) = make_int4(ti[0], ti[1], ti[2], ti[3]); *(int4*)(TPOS + row * 4) = make_int4(rk[0], rk[1], rk[2], rk[3]);
                    *(f32x4*)(GATE + row * 4) = (f32x4){inv, e1 * inv, e2 * inv, e3 * inv};
                }
            } else {
                const float* bg = inp(F, IN_ML_B_GATE);
                float* G32 = WSP(float, WS_G32);
                f32x4 o0, o1; const bool isf = (fq >> 1) == 1;
#pragma unroll
                for (int i = 0; i < 4; ++i) {
                    float g = a0[i] + bg[4 * fq + i]; { const float ex = fast_exp(g * (2.0f / 15.0f)); g = 15.0f * (1.0f - 2.0f * fast_rcp(ex + 1.0f)); }
                    if (isf) g = fminf(g, 0.f) - __logf(1.0f + fast_exp(-fabsf(g)));
                    o0[i] = g;
                    float g2 = a1[i] + bg[16 + 4 * fq + i]; { const float ex = fast_exp(g2 * (2.0f / 15.0f)); g2 = 15.0f * (1.0f - 2.0f * fast_rcp(ex + 1.0f)); }
                    if (isf) g2 = fminf(g2, 0.f) - __logf(1.0f + fast_exp(-fabsf(g2)));
                    o1[i] = g2;
                }
                if (rv) { *(f32x4*)(G32 + (size_t)row * 32 + 4 * fq) = o0; *(f32x4*)(G32 + (size_t)row * 32 + 16 + 4 * fq) = o1; }
            }
        }
    }
    if (EXTRA == 1) {
        unsigned* cnt = F.ctl + CW_CNT + layer * 64; int* LIST = WSP(int, WS_LIST);
        __syncthreads();
        if (F.tid < 32) F.MISC[MI_BASE + F.tid] = (int)__hip_atomic_fetch_add(cnt + F.tid, (unsigned)F.MISC[MI_HIST + F.tid], __ATOMIC_RELAXED, __HIP_MEMORY_SCOPE_AGENT);
        __syncthreads();
        for (int t0 = r0; t0 < r1; t0 += 16) {
            const int row = t0 + fr;
            if (fq == 0 && row < r1) {
                const int4 ev = *(const int4*)(TOPE + row * 4); int4 pv = *(const int4*)(TPOS + row * 4);
                pv.x += F.MISC[MI_BASE + ev.x]; pv.y += F.MISC[MI_BASE + ev.y]; pv.z += F.MISC[MI_BASE + ev.z]; pv.w += F.MISC[MI_BASE + ev.w];
                *(int4*)(TPOS + row * 4) = pv;
                LIST[(size_t)ev.x * T_ALL + pv.x] = row; LIST[(size_t)ev.y * T_ALL + pv.y] = row; LIST[(size_t)ev.z * T_ALL + pv.z] = row; LIST[(size_t)ev.w * T_ALL + pv.w] = row;
            }
        }
    }
}

__device__ __forceinline__ void phase_final(Frame& F, int layer) {
    const int lane = F.lane; const float* MOD = WSP(float, WS_MOD); float* XL = F.out; const bf16_t* XB = WSP(bf16_t, WS_XB);
    const int* TOPE = WSP(int, WS_TOPE); const int* TPOS = WSP(int, WS_TPOS); const float* GATE = WSP(float, WS_GATE); const unsigned char* Y = WSP(unsigned char, WS_Y);
    moe_tables(F, layer);
    const int gw = blockIdx.x * 8 + F.wave, NGW = F.G * 8, rpw = (T_LAT + NGW - 1) / NGW;
    const int r0 = T_CTX + gw * rpw, r1 = (r0 + rpw < T_ALL) ? r0 + rpw : T_ALL;
    f32x4 cG[4]; int cgb = -1;
#pragma unroll
    for (int j = 0; j < 4; ++j) cG[j] = (f32x4){0.f, 0.f, 0.f, 0.f};
    for (int rg = r0; rg < r1; rg += 2) {
        unsigned yv[2][4][4]; float g4[2][4]; f32x4 xv[2][4]; bool act[2];
#pragma unroll
        for (int q = 0; q < 2; ++q) { act[q] = rg + q < r1; const int row = act[q] ? rg + q : rg; int e4[4], p4[4];
            const int4 ev = *(const int4*)(TOPE + row * 4), pv = *(const int4*)(TPOS + row * 4); const f32x4 gv = *(const f32x4*)(GATE + row * 4);
            e4[0] = __builtin_amdgcn_readfirstlane(ev.x); e4[1] = __builtin_amdgcn_readfirstlane(ev.y); e4[2] = __builtin_amdgcn_readfirstlane(ev.z); e4[3] = __builtin_amdgcn_readfirstlane(ev.w);
            p4[0] = __builtin_amdgcn_readfirstlane(pv.x); p4[1] = __builtin_amdgcn_readfirstlane(pv.y); p4[2] = __builtin_amdgcn_readfirstlane(pv.z); p4[3] = __builtin_amdgcn_readfirstlane(pv.w);
            g4[q][0] = gv[0]; g4[q][1] = gv[1]; g4[q][2] = gv[2]; g4[q][3] = gv[3];
            const bf16_t* xd = XB + (size_t)row * D;
#pragma unroll
            for (int j2 = 0; j2 < 2; ++j2) { const u32x4 t = *(const u32x4*)(xd + 8 * lane + 512 * j2); xv[q][2 * j2] = (f32x4){bflo(t.x), bfhi(t.x), bflo(t.y), bfhi(t.y)}; xv[q][2 * j2 + 1] = (f32x4){bflo(t.z), bfhi(t.z), bflo(t.w), bfhi(t.w)}; }
            moe_y_load(F, Y, e4, p4, lane, yv[q]); }
#pragma unroll
        for (int q = 0; q < 2; ++q) { const int row = act[q] ? rg + q : rg; const int b9 = (row - T_CTX) >> 12; float* xd = XL + (size_t)(row - T_CTX) * D;
            f32x4 ys[4]; moe_y_sum(yv[q], g4[q], ys);
            if (b9 != cgb) { cgb = b9; const float* gf = MOD + ((size_t)layer * 9 + b9) * 6144 + 5 * 1024;
#pragma unroll
                for (int j = 0; j < 4; ++j) cG[j] = *(const f32x4*)(gf + PN_COL(j)); }
#pragma unroll
            for (int j = 0; j < 4; ++j) if (act[q]) *(f32x4*)(xd + PN_COL(j)) = xv[q][j] + cG[j] * ys[j]; }
    }
}

__device__ __forceinline__ void phase_convz(Frame& F, int jl, int row_lo, int row_hi) {
    const bf16_t* BG = WSP(bf16_t, WS_A0); const bf16_t* V = WSP(bf16_t, WS_A1); unsigned char* Z = WSP(unsigned char, WS_A2);
    const float* cw = inp(F, IN_CONV_W) + jl * 3 * 1024;
    const int lane = F.lane, gw = blockIdx.x * 8 + F.wave, NGW = F.G * 8, rpw = (row_hi - row_lo + NGW - 1) / NGW;
    const int r0 = row_lo + gw * rpw, r1 = (r0 + rpw < row_hi) ? r0 + rpw : row_hi;
    if (r0 >= r1) return;
    float wt[2][3][8];
#pragma unroll
    for (int j = 0; j < 2; ++j)
#pragma unroll
        for (int k = 0; k < 3; ++k) { const float* wp = cw + k * 1024 + 8 * lane + 512 * j; *(f32x4*)&wt[j][k][0] = *(const f32x4*)wp; *(f32x4*)&wt[j][k][4] = *(const f32x4*)(wp + 4); }
    u32x4 pa[2], pc[2];
#pragma unroll
    for (int j = 0; j < 2; ++j) { const int col = 8 * lane + 512 * j; pa[j] = *(const u32x4*)(V + (size_t)(r0 > 0 ? r0 - 1 : 0) * D + col); pc[j] = *(const u32x4*)(V + (size_t)r0 * D + col); }
    for (int rg = r0; rg < r1; rg += 4) {
        u32x4 nx[4][2], bgv[4][2];
#pragma unroll
        for (int q = 0; q < 4; ++q) { const int row = rg + q < r1 ? rg + q : r1 - 1, rn = row + 1 < T_ALL ? row + 1 : T_ALL - 1;
#pragma unroll
            for (int j = 0; j < 2; ++j) { const int col = 8 * lane + 512 * j; nx[q][j] = *(const u32x4*)(V + (size_t)rn * D + col); bgv[q][j] = *(const u32x4*)(BG + (size_t)row * D + col); } }
#pragma unroll
        for (int q = 0; q < 4; ++q) {
            const int row = rg + q;
            if (row < r1) {
                const bool isctx = row < T_CTX; const int t = isctx ? (row & 255) : ((row - T_CTX) & 4095); const int L = isctx ? 256 : 4096;
                const float mp = t != 0 ? 1.0f : 0.f, mn = t != L - 1 ? 1.0f : 0.f;
#pragma unroll
                for (int j = 0; j < 2; ++j) {
                    const u32x4 vm = q == 0 ? pa[j] : (q == 1 ? pc[j] : nx[q - 2][j]), v0 = q == 0 ? pc[j] : nx[q - 1][j], vp = nx[q][j], bg = bgv[q][j];
                    float zz[8];
#pragma unroll
                    for (int e = 0; e < 4; ++e) {
                        const float lo = bflo(bg[e]) * (wt[j][0][2 * e] * mp * bflo(vm[e]) + wt[j][1][2 * e] * bflo(v0[e]) + wt[j][2][2 * e] * mn * bflo(vp[e]));
                        const float hi = bfhi(bg[e]) * (wt[j][0][2 * e + 1] * mp * bfhi(vm[e]) + wt[j][1][2 * e + 1] * bfhi(v0[e]) + wt[j][2][2 * e + 1] * mn * bfhi(vp[e]));
                        zz[2 * e] = __builtin_amdgcn_fmed3f(lo, -448.f, 448.f); zz[2 * e + 1] = __builtin_amdgcn_fmed3f(hi, -448.f, 448.f);
                    }
                    u32x2 o; o.x = pk_fp8x4(zz[0], zz[1], zz[2], zz[3]); o.y = pk_fp8x4(zz[4], zz[5], zz[6], zz[7]);
                    *(u32x2*)(Z + (size_t)row * D + 8 * lane + 512 * j) = o;
                }
            }
        }
#pragma unroll
        for (int j = 0; j < 2; ++j) { pa[j] = nx[2][j]; pc[j] = nx[3][j]; }
    }
}

__device__ __forceinline__ float rope_apply(Frame& F, float x, int d, int row) {
    const int t = (row - T_CTX) & 4095; const int pos = (d < 32) ? (t >> 6) : (t & 63); const int f = d & 15;
    const float* rc = WSP(float, WS_ROPE); const float cs = rc[pos * 16 + f], sn = rc[1024 + pos * 16 + f];
    const float partner = shx(x, 16, d); const float rot = (d & 16) ? partner : -partner;
    return x * cs + rot * sn;
}
__device__ __forceinline__ void phase_mla_n1(Frame& F) {
    const bf16_t* DN = WSP(bf16_t, WS_A0); bf16_t* CQN = WSP(bf16_t, WS_A6); bf16_t* CKVN = WSP(bf16_t, WS_A6 + 26 * MiB); unsigned char* KR = WSP(unsigned char, WS_A6 + 44 * MiB);
    const float* qg = inp(F, IN_MLA_Q_NORM); const float* kvg = inp(F, IN_MLA_KV_NORM); const float* krg = inp(F, IN_MLA_KN_ROPE);
    const int lane = F.lane;
    f32x2 gq[3], gkv[2];
#pragma unroll
    for (int i = 0; i < 3; ++i) gq[i] = *(const f32x2*)(qg + 2 * lane + 128 * i);
#pragma unroll
    for (int i = 0; i < 2; ++i) gkv[i] = *(const f32x2*)(kvg + 2 * lane + 128 * i);
    const float gkr = krg[lane];
    const int gw = blockIdx.x * 8 + F.wave, NGW = F.G * 8, rpw = (T_ALL + NGW - 1) / NGW;
    const int r0 = gw * rpw, r1 = (r0 + rpw < T_ALL) ? r0 + rpw : T_ALL;
    for (int rg = r0; rg < r1; rg += 2) {
        f32x2 q[2][3], kv[2][2]; float kr[2]; bool act[2];
#pragma unroll
        for (int u = 0; u < 2; ++u) { act[u] = rg + u < r1; const int row = act[u] ? rg + u : rg; const bf16_t* dp = DN + (size_t)row * 768;
#pragma unroll
            for (int i = 0; i < 3; ++i) { const unsigned t = *(const unsigned*)(dp + 2 * lane + 128 * i); q[u][i] = (f32x2){bflo(t), bfhi(t)}; }
#pragma unroll
            for (int i = 0; i < 2; ++i) { const unsigned t = *(const unsigned*)(dp + 384 + 2 * lane + 128 * i); kv[u][i] = (f32x2){bflo(t), bfhi(t)}; }
            kr[u] = bf1(dp[640 + lane]); }
#pragma unroll
        for (int u = 0; u < 2; ++u) { const int row = act[u] ? rg + u : rg;
            float ss = 0.f;
#pragma unroll
            for (int i = 0; i < 3; ++i) ss += q[u][i].x * q[u][i].x + q[u][i].y * q[u][i].y;
            const float rq = 1.0f / sqrtf(wave_sum_fast(ss, lane) * (1.0f / 384.0f) + RMS_EPS);
            ss = 0.f;
#pragma unroll
            for (int i = 0; i < 2; ++i) ss += kv[u][i].x * kv[u][i].x + kv[u][i].y * kv[u][i].y;
            const float rkv = 1.0f / sqrtf(wave_sum_fast(ss, lane) * (1.0f / 256.0f) + RMS_EPS);
            const float rkr = 1.0f / sqrtf(wave_sum_fast(kr[u] * kr[u], lane) * (1.0f / 64.0f) + RMS_EPS);
            float krv = kr[u] * rkr * gkr;
            if (row >= T_CTX) krv = rope_apply(F, krv, lane, row);
            if (act[u]) {
#pragma unroll
                for (int i = 0; i < 3; ++i) *(unsigned*)(CQN + (size_t)row * 384 + 2 * lane + 128 * i) = cvt_pk_bf16(q[u][i].x * rq * gq[i].x, q[u][i].y * rq * gq[i].y);
#pragma unroll
                for (int i = 0; i < 2; ++i) *(unsigned*)(CKVN + (size_t)row * 256 + 2 * lane + 128 * i) = cvt_pk_bf16(kv[u][i].x * rkv * gkv[i].x, kv[u][i].y * rkv * gkv[i].y);
                KR[(size_t)row * 64 + lane] = (unsigned char)(pk_fp8x4(__builtin_amdgcn_fmed3f(krv, -448.f, 448.f), 0.f, 0.f, 0.f) & 0xffu); }
        }
    }
}
constexpr float QSCALE = 0.07216878364870322f * 1.4426950408889634f;
__device__ __forceinline__ float sum8(float v) {
    v += __int_as_float(__builtin_amdgcn_update_dpp(0, __float_as_int(v), 0xB1, 0xF, 0xF, true));
    v += __int_as_float(__builtin_amdgcn_update_dpp(0, __float_as_int(v), 0x4E, 0xF, 0xF, true));
    v += __int_as_float(__builtin_amdgcn_update_dpp(0, __float_as_int(v), 0x141, 0xF, 0xF, true));
    return v;
}
__device__ __forceinline__ float dpp_xor2(float v) { return __int_as_float(__builtin_amdgcn_update_dpp(0, __float_as_int(v), 0x4E, 0xF, 0xF, true)); }
__device__ __forceinline__ void phase_mla_n2(Frame& F) {
    const bf16_t* KNRAW = WSP(bf16_t, WS_A3); unsigned char* KN = WSP(unsigned char, WS_A4);
    const float* gk = inp(F, IN_MLA_KN_NOPE);
    const int lane = F.lane, hd = lane >> 3, sub = lane & 7;
    float gkv[16];
#pragma unroll
    for (int i = 0; i < 4; ++i) *(f32x4*)&gkv[4 * i] = *(const f32x4*)(gk + sub * 16 + 4 * i);
    const int gw = blockIdx.x * 8 + F.wave, NGW = F.G * 8, rpw = (T_ALL + NGW - 1) / NGW;
    const int r0 = gw * rpw, r1 = (r0 + rpw < T_ALL) ? r0 + rpw : T_ALL;
    for (int rg = r0; rg < r1; rg += 4) {
        u32x4 kn[4][2]; bool act[4];
#pragma unroll
        for (int u = 0; u < 4; ++u) { act[u] = rg + u < r1; const int row = act[u] ? rg + u : rg; const bf16_t* kp = KNRAW + (size_t)row * 1024 + hd * 128 + sub * 16;
            kn[u][0] = *(const u32x4*)(kp); kn[u][1] = *(const u32x4*)(kp + 8); }
#pragma unroll
        for (int u = 0; u < 4; ++u) { const int row = act[u] ? rg + u : rg;
            float k[16];
#pragma unroll
            for (int i = 0; i < 4; ++i) { k[2 * i] = bflo(kn[u][0][i]); k[2 * i + 1] = bfhi(kn[u][0][i]); k[8 + 2 * i] = bflo(kn[u][1][i]); k[8 + 2 * i + 1] = bfhi(kn[u][1][i]); }
            float sk = 0.f;
#pragma unroll
            for (int i = 0; i < 16; ++i) sk += k[i] * k[i];
            const float rk = 1.0f / sqrtf(sum8(sk) * (1.0f / 128.0f) + RMS_EPS);
            if (act[u]) { unsigned char* ko = KN + (size_t)row * 1024 + hd * 128 + sub * 16; u32x4 k0;
#pragma unroll
                for (int i = 0; i < 4; ++i) k0[i] = pk_fp8x4(__builtin_amdgcn_fmed3f(k[4 * i] * rk * gkv[4 * i], -448.f, 448.f), __builtin_amdgcn_fmed3f(k[4 * i + 1] * rk * gkv[4 * i + 1], -448.f, 448.f),
                                                           __builtin_amdgcn_fmed3f(k[4 * i + 2] * rk * gkv[4 * i + 2], -448.f, 448.f), __builtin_amdgcn_fmed3f(k[4 * i + 3] * rk * gkv[4 * i + 3], -448.f, 448.f));
                *(u32x4*)(ko) = k0; }
        }
    }
}

constexpr int AT_KSTR = 208, AT_VSTR = 80, AT_KBYTES = 128 * AT_KSTR, AT_VSUB = 128 * AT_VSTR, AT_VBYTES = 2 * AT_VSUB;
#define MFMA8U(a, b, c) __builtin_amdgcn_mfma_scale_f32_32x32x64_f8f6f4(a, b, c, 0, 0, 0, 0x7f7f7f7f, 0, 0x7f7f7f7f)
#define MFMA8S(a, b, c) __builtin_amdgcn_mfma_scale_f32_32x32x64_f8f6f4(a, b, c, 0, 0, 0, 0x7f7f7f7f, 0, 0x7b7b7b7b)
__device__ __forceinline__ float c8(float x) { return __builtin_amdgcn_fmed3f(x, -448.f, 448.f); }
__device__ __forceinline__ void phase_attn(Frame& F) {
    const bf16_t* Q = WSP(bf16_t, WS_A1);
    const float* gqn = inp(F, IN_MLA_QN_NOPE); const float* gqr = inp(F, IN_MLA_QN_ROPE); const float* ropet = WSP(float, WS_ROPE);
    const unsigned char* KN = WSP(unsigned char, WS_A4); const unsigned char* KR = WSP(unsigned char, WS_A6 + 44 * MiB); const unsigned char* VT = WSP(unsigned char, WS_A5);
    unsigned char* O = WSP(unsigned char, WS_A6 + 50 * MiB);
    const int tid = F.tid, lane = F.lane, w = F.wave, r = lane & 31, hh = lane >> 5;
    LAS unsigned char* KB = F.lds; LAS unsigned char* VB = F.lds + 2 * AT_KBYTES;
    const int NU = 1024 + 64;
    for (int L = F.vcu; L < NU; L += F.G) {
        int b, h, qrow0, ntile; bool lat;
        if (L < 1024) { const int bh = L >> 4, qb = L & 15; b = bh >> 3; h = bh & 7; qrow0 = T_CTX + b * SEQ + qb * 256; ntile = 34; lat = true; }
        else { const int Lc = L - 1024; b = Lc >> 3; h = Lc & 7; qrow0 = b * CTXL; ntile = 2; lat = false; }
        const int qrow = qrow0 + 32 * w + r;
        v8i Qf[3];
        {
            u32x4 qraw[12]; float ssn = 0.f, ssr = 0.f;
#pragma unroll
            for (int q = 0; q < 12; ++q) { qraw[q] = *(const u32x4*)(Q + (size_t)qrow * 1536 + h * 192 + 64 * (q >> 2) + 32 * hh + 8 * (q & 3));
                float sq = 0.f;
#pragma unroll
                for (int i = 0; i < 4; ++i) { const float lo = bflo(qraw[q][i]), hi = bfhi(qraw[q][i]); sq += lo * lo + hi * hi; }
                if (q < 8) ssn += sq; else ssr += sq; }
            ssn += shx(ssn, 32, lane); ssr += shx(ssr, 32, lane);
            const float rn = (16.0f * QSCALE) / sqrtf(ssn * (1.0f / 128.0f) + RMS_EPS), rr = 1.0f / sqrtf(ssr * (1.0f / 64.0f) + RMS_EPS);
#pragma unroll
            for (int ks = 0; ks < 2; ++ks)
#pragma unroll
                for (int c = 0; c < 4; ++c) { const f32x4 g0 = *(const f32x4*)(gqn + 64 * ks + 32 * hh + 8 * c), g1 = *(const f32x4*)(gqn + 64 * ks + 32 * hh + 8 * c + 4); const u32x4 qr = qraw[4 * ks + c];
                    Qf[ks][2 * c] = (int)pk_fp8x4(c8(bflo(qr.x) * rn * g0[0]), c8(bfhi(qr.x) * rn * g0[1]), c8(bflo(qr.y) * rn * g0[2]), c8(bfhi(qr.y) * rn * g0[3]));
                    Qf[ks][2 * c + 1] = (int)pk_fp8x4(c8(bflo(qr.z) * rn * g1[0]), c8(bfhi(qr.z) * rn * g1[1]), c8(bflo(qr.w) * rn * g1[2]), c8(bfhi(qr.w) * rn * g1[3])); }
            const int tq = (qrow - T_CTX) & 4095, pos = hh == 0 ? (tq >> 6) : (tq & 63);
#pragma unroll
            for (int c = 0; c < 2; ++c) {
                float x1[8], x2[8], gg1[8], gg2[8], cs[8], sn[8];
                *(f32x4*)&gg1[0] = *(const f32x4*)(gqr + 32 * hh + 8 * c); *(f32x4*)&gg1[4] = *(const f32x4*)(gqr + 32 * hh + 8 * c + 4);
                *(f32x4*)&gg2[0] = *(const f32x4*)(gqr + 32 * hh + 16 + 8 * c); *(f32x4*)&gg2[4] = *(const f32x4*)(gqr + 32 * hh + 16 + 8 * c + 4);
                *(f32x4*)&cs[0] = *(const f32x4*)(ropet + pos * 16 + 8 * c); *(f32x4*)&cs[4] = *(const f32x4*)(ropet + pos * 16 + 8 * c + 4);
                *(f32x4*)&sn[0] = *(const f32x4*)(ropet + 1024 + pos * 16 + 8 * c); *(f32x4*)&sn[4] = *(const f32x4*)(ropet + 1024 + pos * 16 + 8 * c + 4);
#pragma unroll
                for (int i = 0; i < 4; ++i) { x1[2 * i] = bflo(qraw[8 + c][i]) * rr * gg1[2 * i]; x1[2 * i + 1] = bfhi(qraw[8 + c][i]) * rr * gg1[2 * i + 1];
                    x2[2 * i] = bflo(qraw[10 + c][i]) * rr * gg2[2 * i]; x2[2 * i + 1] = bfhi(qraw[10 + c][i]) * rr * gg2[2 * i + 1]; }
#pragma unroll
                for (int j = 0; j < 8; ++j) {
                    float a0 = x1[j], b0 = x2[j];
                    if (lat) { const float na = a0 * cs[j] - b0 * sn[j], nb = b0 * cs[j] + a0 * sn[j]; a0 = na; b0 = nb; }
                    x1[j] = c8(a0 * (16.0f * QSCALE)); x2[j] = c8(b0 * (16.0f * QSCALE)); }
                Qf[2][2 * c] = (int)pk_fp8x4(x1[0], x1[1], x1[2], x1[3]); Qf[2][2 * c + 1] = (int)pk_fp8x4(x1[4], x1[5], x1[6], x1[7]);
                Qf[2][4 + 2 * c] = (int)pk_fp8x4(x2[0], x2[1], x2[2], x2[3]); Qf[2][4 + 2 * c + 1] = (int)pk_fp8x4(x2[4], x2[5], x2[6], x2[7]);
            }
        }
        u32x4 kreg[3], vreg[2];
        auto tile_row0 = [&](int t) { return lat ? (t < 32 ? T_CTX + b * SEQ + 128 * t : b * CTXL + 128 * (t - 32)) : b * CTXL + 128 * t; };
        const unsigned kofs0 = (unsigned)((tid >> 3) * 1024 + 16 * (tid & 7)), vofs0 = (unsigned)(tid * 16);
        const unsigned kl0 = (unsigned)((tid >> 3) * AT_KSTR + (tid & 7) * 16), kl2 = (unsigned)((tid >> 2) * AT_KSTR + 128 + (tid & 3) * 16);
        const unsigned vl0 = (unsigned)((tid >> 2) * AT_VSTR + (tid & 3) * 16);
#define AT_LOAD(t) do { const int kr0_ = tile_row0(t); const unsigned char* knu_ = KN + (size_t)kr0_ * 1024 + h * 128; const unsigned char* kru_ = KR + (size_t)kr0_ * 64; const unsigned char* vtu_ = VT + ((size_t)(kr0_ >> 6) * 1024 + h * 128) * 64; \
        kreg[0] = *(const u32x4*)(knu_ + kofs0); kreg[1] = *(const u32x4*)(knu_ + kofs0 + 64u * 1024u); kreg[2] = *(const u32x4*)(kru_ + vofs0); \
        vreg[0] = *(const u32x4*)(vtu_ + vofs0); vreg[1] = *(const u32x4*)(vtu_ + vofs0 + 65536u); } while (0)
#define AT_STORE(buf) do { LAS unsigned char* kd_ = KB + (buf) * AT_KBYTES; LAS unsigned char* vd_ = VB + (buf) * AT_VBYTES; \
        *(LAS u32x4*)(kd_ + kl0) = kreg[0]; *(LAS u32x4*)(kd_ + kl0 + 64 * AT_KSTR) = kreg[1]; *(LAS u32x4*)(kd_ + kl2) = kreg[2]; \
        *(LAS u32x4*)(vd_ + vl0) = vreg[0]; *(LAS u32x4*)(vd_ + AT_VSUB + vl0) = vreg[1]; } while (0)
        __syncthreads();
        AT_LOAD(0); AT_STORE(0);
        __syncthreads();
        int first = 1; asm volatile("" : "+s"(first));
        float m_run = 0.f, l_run = 0.f;
        f32x16 o[4];
#pragma unroll
        for (int vb = 0; vb < 4; ++vb)
#pragma unroll
            for (int i = 0; i < 16; ++i) o[vb][i] = 0.f;
        for (int t = 0; t < ntile; ++t) {
            const int buf = t & 1;
#pragma unroll
          for (int sub = 0; sub < 2; ++sub) {
            f32x16 s0, s1;
            { const float nm = -m_run;
#pragma unroll
              for (int i = 0; i < 16; ++i) { s0[i] = nm; s1[i] = nm; } }
            {
                const LAS unsigned char* kb = KB + buf * AT_KBYTES + (64 * sub + r) * AT_KSTR + hh * 32;
                v8i ka[2][2];
#define AT_LDK(dst, ks_) do { _Pragma("unroll") for (int kb_ = 0; kb_ < 2; ++kb_) { const u32x4 lo_ = *(const LAS u32x4*)(kb + kb_ * 32 * AT_KSTR + (ks_) * 64), hi_ = *(const LAS u32x4*)(kb + kb_ * 32 * AT_KSTR + (ks_) * 64 + 16); \
        dst[kb_] = (v8i){(int)lo_.x, (int)lo_.y, (int)lo_.z, (int)lo_.w, (int)hi_.x, (int)hi_.y, (int)hi_.z, (int)hi_.w}; } } while (0)
                AT_LDK(ka[0], 0); AT_LDK(ka[1], 1);
#pragma unroll
                for (int ks = 0; ks < 3; ++ks) {
                    __builtin_amdgcn_sched_barrier(0);
                    s0 = MFMA8S(ka[ks & 1][0], Qf[ks], s0); s1 = MFMA8S(ka[ks & 1][1], Qf[ks], s1);
                    if (ks == 0) AT_LDK(ka[0], 2);
                }
                __builtin_amdgcn_sched_barrier(0);
#undef AT_LDK
            }
            if (sub == 0 && t + 1 < ntile) AT_LOAD(t + 1);
            v8i va[4];
            { const LAS unsigned char* vbp = VB + buf * AT_VBYTES + sub * AT_VSUB + r * AT_VSTR + hh * 32;
#pragma unroll
              for (int vb = 0; vb < 4; ++vb) { const u32x4 lo_ = *(const LAS u32x4*)(vbp + vb * 32 * AT_VSTR), hi_ = *(const LAS u32x4*)(vbp + vb * 32 * AT_VSTR + 16);
                  va[vb] = (v8i){(int)lo_.x, (int)lo_.y, (int)lo_.z, (int)lo_.w, (int)hi_.x, (int)hi_.y, (int)hi_.z, (int)hi_.w}; } }
            __builtin_amdgcn_sched_barrier(0);
            float mx = s0[0];
#pragma unroll
            for (int i = 1; i < 16; ++i) mx = fmaxf(mx, s0[i]);
#pragma unroll
            for (int i = 0; i < 16; ++i) mx = fmaxf(mx, s1[i]);
            mx = fmaxf(mx, shx(mx, 32, lane));
            if (first | (int)(__builtin_amdgcn_ballot_w64(mx > 8.0f) != 0ull)) {
                const float d = (first || mx > 8.0f) ? mx - 6.0f : 0.f, alpha = first ? 0.f : __builtin_amdgcn_exp2f(-d);
                first = 0;
                m_run += d; l_run *= alpha;
#pragma unroll
                for (int i = 0; i < 16; ++i) { s0[i] -= d; s1[i] -= d; }
#pragma unroll
                for (int vb = 0; vb < 4; ++vb)
#pragma unroll
                    for (int i = 0; i < 16; ++i) o[vb][i] *= alpha;
            }
            float ls = 0.f;
#pragma unroll
            for (int i = 0; i < 16; ++i) { s0[i] = __builtin_amdgcn_exp2f(s0[i]); s1[i] = __builtin_amdgcn_exp2f(s1[i]); ls += s0[i] + s1[i]; }
            l_run += ls;
            v8i pf;
#pragma unroll
            for (int i = 0; i < 4; ++i) { pf[i] = (int)pk_fp8x4(s0[4 * i], s0[4 * i + 1], s0[4 * i + 2], s0[4 * i + 3]); pf[4 + i] = (int)pk_fp8x4(s1[4 * i], s1[4 * i + 1], s1[4 * i + 2], s1[4 * i + 3]); }
            __builtin_amdgcn_sched_barrier(0);
#pragma unroll
            for (int vb = 0; vb < 4; ++vb) o[vb] = MFMA8U(va[vb], pf, o[vb]);
            __builtin_amdgcn_sched_barrier(0);
          }
            if (t + 1 < ntile) AT_STORE(buf ^ 1);
            __syncthreads();
        }
        const float lt = l_run + shx(l_run, 32, lane), inv = 1.0f / lt;
        unsigned char* op = O + (size_t)qrow * 1024 + h * 128 + 4 * hh;
#pragma unroll
        for (int vb = 0; vb < 4; ++vb)
#pragma unroll
            for (int g = 0; g < 4; ++g) *(unsigned*)(op + 32 * vb + 8 * g) = pk_fp8x4(o[vb][4 * g] * inv, o[vb][4 * g + 1] * inv, o[vb][4 * g + 2] * inv, o[vb][4 * g + 3] * inv);
#undef AT_LOAD
#undef AT_STORE
    }
}

__device__ __forceinline__ int ml_block_of_chunk(int dir, int ci) { return dir == 0 ? ci : (ci < 4 ? 3 - ci : 71 - ci); }
__device__ __forceinline__ int ml_rowbase(int b, int j) { return j < 4 ? b * CTXL + 64 * j : T_CTX + b * SEQ + 64 * (j - 4); }
__device__ __forceinline__ void phase_ml_scan_gates(Frame& F) {
    const float* G32 = WSP(float, WS_G32);
    float* SU = WSP(float, WS_SCU); float* SMU = WSP(float, WS_SCMU); float* SB = WSP(float, WS_SCB); float* CHM = WSP(float, WS_CHM); float* CHMU = CHM + 16384;
    volatile LAS float* sbl = (volatile LAS float*)(F.MISC + MI_SCR); volatile LAS float* sM = sbl + 72; volatile LAS float* smc = sM + 72;
    const int lane = F.lane;
    for (int chain = (F.G >= 256) ? (int)blockIdx.x - 128 : (int)blockIdx.x; chain >= 0 && chain < 128; chain += F.G) {
        const int dir = chain >> 6, b = (chain >> 3) & 7, h = chain & 7;
        const int gi = dir * 16 + h, gf = dir * 16 + 8 + h;
        float bb[9], uu[9], MM[9];
#pragma unroll
        for (int k = 0; k < 9; ++k) {
            const int ci = F.wave + 8 * k; bb[k] = 0.f; uu[k] = 0.f; MM[k] = 0.f;
            if (ci < NCHUNK) {
                const int rb = ml_rowbase(b, ml_block_of_chunk(dir, ci)); const int row = dir ? rb + 63 - lane : rb + lane;
                const float iv = G32[(size_t)row * 32 + gi]; float bsum = G32[(size_t)row * 32 + gf];
#pragma unroll
                for (int o = 1; o < 64; o <<= 1) { const float t = shup(bsum, o, lane); if (lane >= o) bsum += t; }
                const float u = iv - bsum; float M = u;
#pragma unroll
                for (int o = 1; o < 64; o <<= 1) { const float t = shup(M, o, lane); if (lane >= o) M = fmaxf(M, t); }
                bb[k] = bsum; uu[k] = u; MM[k] = M;
                if (lane == 63) { sbl[ci] = bsum; sM[ci] = M; }
            }
        }
        __syncthreads();
        if (F.tid == 0) { float m = 0.f; for (int ci = 0; ci < NCHUNK; ++ci) { smc[ci] = m; m = sbl[ci] + fmaxf(m, sM[ci]); } }
        __syncthreads();
#pragma unroll
        for (int k = 0; k < 9; ++k) {
            const int ci = F.wave + 8 * k;
            if (ci < NCHUNK) {
                const int rb = ml_rowbase(b, ml_block_of_chunk(dir, ci)); const int row = dir ? rb + 63 - lane : rb + lane;
                const float mc = smc[ci]; const size_t o = ((size_t)(dir * 8 + h)) * T_ALL + row;
                SU[o] = uu[k]; SMU[o] = fmaxf(mc, MM[k]); SB[o] = bb[k];
                if (lane == 0) { CHM[chain * NCHUNK + ci] = mc; CHMU[chain * NCHUNK + ci] = fmaxf(mc, sM[ci]); }
            }
        }
        __syncthreads();
    }
}
constexpr int MS_STR = 144, MS_TILE = 64 * MS_STR, MS_STEP = 2 * MS_TILE + 256, MS_GRP = 2 * MS_STEP;
__device__ __forceinline__ void phase_ml_state(Frame& F) {
    const bf16_t* KTV = WSP(bf16_t, WS_A2);
    const float* SU = WSP(float, WS_SCU); const float* CHM = WSP(float, WS_CHM); const float* CHMU = CHM + 16384;
    bf16_t* CST = WSP(bf16_t, WS_A5); float* NST = WSP(float, WS_NST);
    const int tid = F.tid, lane = F.lane, w = F.wave, fr = lane & 15, fq = lane >> 4, ti = w >> 1, tj0 = 2 * (w & 1);
    LAS unsigned char* L = F.lds;
    bf16x8 ones; { u32x4 t = (u32x4){0x3f803f80u, 0x3f803f80u, 0x3f803f80u, 0x3f803f80u}; ones = __builtin_bit_cast(bf16x8, t); }
    const unsigned pl = (unsigned)((tid >> 3) * MS_STR + (tid & 7) * 16);
    for (int unit = blockIdx.x; unit < 256; unit += F.G) {
        const int chain = unit >> 1, vh = unit & 1, dir = chain >> 6, b = (chain >> 3) & 7, h = chain & 7;
        f32x4 acc[2] = {(f32x4){0.f, 0.f, 0.f, 0.f}, (f32x4){0.f, 0.f, 0.f, 0.f}}, nacc = (f32x4){0.f, 0.f, 0.f, 0.f};
        const bf16_t* kbase = KTV + (size_t)(h * 64) * 64 + tid * 8; const bf16_t* vbase = KTV + (size_t)(512 + h * 128 + vh * 64) * 64 + tid * 8;
        const float* ubase = SU + (size_t)(dir * 8 + h) * T_ALL + (tid & 63);
        u32x4 sk[2], sv[2]; float su = 0.f, mcn[2], mun[2], mcc[2], muc[2];
#define MS_LOAD(g_) do { _Pragma("unroll") for (int s_ = 0; s_ < 2; ++s_) { const int ci_ = 2 * (g_) + s_, rb_ = ml_rowbase(b, ml_block_of_chunk(dir, ci_)); const size_t bo_ = (size_t)(rb_ >> 6) * (1536 * 64); \
            sk[s_] = *(const u32x4*)(kbase + bo_); sv[s_] = *(const u32x4*)(vbase + bo_); if ((tid >> 6) == s_) su = ubase[rb_]; \
            mcn[s_] = CHM[chain * NCHUNK + ci_]; mun[s_] = CHMU[chain * NCHUNK + ci_]; } } while (0)
#define MS_STORE(buf_) do { _Pragma("unroll") for (int s_ = 0; s_ < 2; ++s_) { LAS unsigned char* d_ = L + (buf_) * MS_GRP + s_ * MS_STEP; \
            *(LAS u32x4*)(d_ + pl) = sk[s_]; *(LAS u32x4*)(d_ + MS_TILE + pl) = sv[s_]; if ((tid >> 6) == s_) *(LAS float*)(d_ + 2 * MS_TILE + (tid & 63) * 4) = su; } } while (0)
        __syncthreads();
        MS_LOAD(0); MS_STORE(0); mcc[0] = mcn[0]; mcc[1] = mcn[1]; muc[0] = mun[0]; muc[1] = mun[1];
        MS_LOAD(1);
        __syncthreads();
        for (int g = 0; g < NCHUNK / 2; ++g) {
            const LAS unsigned char* gb = L + (g & 1) * MS_GRP;
#pragma unroll
            for (int s = 0; s < 2; ++s) {
                const int ci = 2 * g + s; const float mu63 = muc[s], alpha = fast_exp(mcc[s] - mu63);
                const LAS unsigned char* sb = gb + s * MS_STEP;
                u32x4 kav[2]; f32x4 u0[2], u1[2]; bf16x8 b0[2], b1[2];
#pragma unroll
                for (int ks = 0; ks < 2; ++ks) { kav[ks] = *(const LAS u32x4*)(sb + (16 * ti + fr) * MS_STR + (32 * ks + 8 * fq) * 2);
                    b0[ks] = *(const LAS bf16x8*)(sb + MS_TILE + (16 * tj0 + fr) * MS_STR + (32 * ks + 8 * fq) * 2); b1[ks] = *(const LAS bf16x8*)(sb + MS_TILE + (16 * tj0 + 16 + fr) * MS_STR + (32 * ks + 8 * fq) * 2);
                    u0[ks] = *(const LAS f32x4*)(sb + 2 * MS_TILE + (32 * ks + 8 * fq) * 4); u1[ks] = *(const LAS f32x4*)(sb + 2 * MS_TILE + (32 * ks + 8 * fq) * 4 + 16); }
                { bf16_t* cp = CST + ((size_t)chain * NCHUNK + ci) * 8192 + ((vh * 4 + tj0) * 4 + ti) * 256 + fr * 16 + 4 * fq;
                  u32x2 s0; s0.x = cvt_pk_bf16(acc[0][0], acc[0][1]); s0.y = cvt_pk_bf16(acc[0][2], acc[0][3]); *(u32x2*)cp = s0;
                  u32x2 s1; s1.x = cvt_pk_bf16(acc[1][0], acc[1][1]); s1.y = cvt_pk_bf16(acc[1][2], acc[1][3]); *(u32x2*)(cp + 4 * 256) = s1;
                  if (vh == 0 && (w & 1) == 0 && fr == 0) *(f32x4*)(NST + ((size_t)chain * NCHUNK + ci) * 64 + 16 * ti + 4 * fq) = nacc; }
                acc[0] = acc[0] * alpha; acc[1] = acc[1] * alpha; nacc = nacc * alpha;
#pragma unroll
                for (int ks = 0; ks < 2; ++ks) {
                    const u32x4 ka = kav[ks]; u32x4 aw;
                    aw.x = cvt_pk_bf16(bflo(ka.x) * fast_exp(u0[ks][0] - mu63), bfhi(ka.x) * fast_exp(u0[ks][1] - mu63));
                    aw.y = cvt_pk_bf16(bflo(ka.y) * fast_exp(u0[ks][2] - mu63), bfhi(ka.y) * fast_exp(u0[ks][3] - mu63));
                    aw.z = cvt_pk_bf16(bflo(ka.z) * fast_exp(u1[ks][0] - mu63), bfhi(ka.z) * fast_exp(u1[ks][1] - mu63));
                    aw.w = cvt_pk_bf16(bflo(ka.w) * fast_exp(u1[ks][2] - mu63), bfhi(ka.w) * fast_exp(u1[ks][3] - mu63));
                    const bf16x8 A = __builtin_bit_cast(bf16x8, aw);
                    acc[0] = MFMA16(A, b0[ks], acc[0]); acc[1] = MFMA16(A, b1[ks], acc[1]); nacc = MFMA16(A, ones, nacc); }
            }
            if (g + 1 < NCHUNK / 2) { MS_STORE((g + 1) & 1); mcc[0] = mcn[0]; mcc[1] = mcn[1]; muc[0] = mun[0]; muc[1] = mun[1]; }
            if (g + 2 < NCHUNK / 2) MS_LOAD(g + 2);
            __syncthreads();
        }
#undef MS_LOAD
#undef MS_STORE
    }
}
constexpr int MO_S144 = 144, MO_S136 = 136, MO_S264 = 264;
constexpr int MO_K = 0, MO_Q = 64 * MO_S144, MO_V = 2 * 64 * MO_S144, MO_C0 = MO_V + 128 * MO_S136, MO_C1 = MO_C0 + 128 * MO_S144, MO_O = MO_C1 + 128 * MO_S144, MO_SM = MO_O + 64 * MO_S264, MO_END = MO_SM + 2048 + 64;
__device__ __forceinline__ void phase_ml_out(Frame& F) {
    const bf16_t* Qb = WSP(bf16_t, WS_A0); const bf16_t* Kb = Qb + (size_t)T_ALL * 512; const bf16_t* Ob = WSP(bf16_t, WS_A1);
    const bf16_t* KTV = WSP(bf16_t, WS_A2);
    const float* SU = WSP(float, WS_SCU); const float* SMU = WSP(float, WS_SCMU); const float* SB = WSP(float, WS_SCB); const float* CHM = WSP(float, WS_CHM);
    const bf16_t* CST = WSP(bf16_t, WS_A5); const float* NST = WSP(float, WS_NST);
    unsigned char* HN = WSP(unsigned char, WS_A3); const float* ng = inp(F, IN_ML_NORM);
    volatile LAS float* part = (volatile LAS float*)(F.MISC + MI_SCR);
    LAS unsigned char* L = F.lds;
    const LAS float* SM = (const LAS float*)(F.lds + MO_SM);
    const int tid = F.tid, lane = F.lane, w = F.wave, r = lane & 31, hh = lane >> 5, tb = w & 1, vb = w >> 1;
    const int srow = tid >> 3, sc = tid & 7, orow = tid >> 4, oc = tid & 15;
    const int sq = tid >> 7, sdir = (tid >> 6) & 1, si = tid & 63;
    u32x4 stg[10]; float ssm, scm;
#define MO_G(T, off_) (*(const T*)(F.ws + (size_t)(unsigned)(off_)))
#define MO_LOAD(unit_) do { const int bh_ = (unit_) / NCHUNK, j_ = (unit_) % NCHUNK, b_ = bh_ >> 3, h_ = bh_ & 7, rb_ = ml_rowbase(b_, j_); \
        const int cf_ = ((0 * 8 + b_) * 8 + h_) * NCHUNK + j_, cb_ = ((1 * 8 + b_) * 8 + h_) * NCHUNK + (j_ < 4 ? 3 - j_ : 71 - j_); \
        const unsigned qk_ = (unsigned)(((rb_ + srow) * 512 + h_ * 64 + 8 * sc) * 2); \
        stg[0] = MO_G(u32x4, (unsigned)WS_A0 + (unsigned)T_ALL * 1024u + qk_); stg[1] = MO_G(u32x4, (unsigned)WS_A0 + qk_); \
        const unsigned vt_ = (unsigned)WS_A2 + (unsigned)((((rb_ >> 6) * 1536 + 512 + h_ * 128) * 64 + tid * 8) * 2); stg[2] = MO_G(u32x4, vt_); stg[3] = MO_G(u32x4, vt_ + 8192u); \
        const unsigned c0_ = (unsigned)WS_A5 + (unsigned)(cf_ * 16384 + tid * 16), c1_ = (unsigned)WS_A5 + (unsigned)(cb_ * 16384 + tid * 16); \
        stg[4] = MO_G(u32x4, c0_); stg[5] = MO_G(u32x4, c0_ + 8192u); stg[6] = MO_G(u32x4, c1_); stg[7] = MO_G(u32x4, c1_ + 8192u); \
        const unsigned ob_ = (unsigned)WS_A1 + (unsigned)(((rb_ + orow) * 1024 + h_ * 128 + 8 * oc) * 2); stg[8] = MO_G(u32x4, ob_); stg[9] = MO_G(u32x4, ob_ + 32u * 2048u); \
        { const unsigned so_ = (unsigned)(((sdir * 8 + h_) * T_ALL + rb_ + si) * 4); const int cc_ = sdir ? cb_ : cf_; \
          const unsigned sa_ = sq < 3 ? (unsigned)WS_SCU + (unsigned)sq * (unsigned)(WS_SCMU - WS_SCU) + so_ : (unsigned)WS_NST + (unsigned)((cc_ * 64 + si) * 4); \
          ssm = MO_G(float, sa_); scm = MO_G(float, (unsigned)WS_CHM + (unsigned)((lane & 1 ? cb_ : cf_) * 4)); } } while (0)
#define MO_STORE() do { *(LAS u32x4*)(L + MO_K + srow * MO_S144 + sc * 16) = stg[0]; *(LAS u32x4*)(L + MO_Q + srow * MO_S144 + sc * 16) = stg[1]; \
        { LAS unsigned char* d_ = L + MO_V + srow * MO_S136 + sc * 16; *(LAS u32x2*)d_ = (u32x2){stg[2].x, stg[2].y}; *(LAS u32x2*)(d_ + 8) = (u32x2){stg[2].z, stg[2].w}; \
          d_ += 64 * MO_S136; *(LAS u32x2*)d_ = (u32x2){stg[3].x, stg[3].y}; *(LAS u32x2*)(d_ + 8) = (u32x2){stg[3].z, stg[3].w}; } \
        { int t_ = tid; asm volatile("" : "+v"(t_)); const int cpos_ = (16 * (t_ >> 7) + ((t_ & 31) >> 1)) * MO_S144 + (16 * ((t_ >> 5) & 3) + 8 * (t_ & 1)) * 2;     \
          *(LAS u32x4*)(L + MO_C0 + cpos_) = stg[4]; *(LAS u32x4*)(L + MO_C0 + 64 * MO_S144 + cpos_) = stg[5]; \
          *(LAS u32x4*)(L + MO_C1 + cpos_) = stg[6]; *(LAS u32x4*)(L + MO_C1 + 64 * MO_S144 + cpos_) = stg[7]; } \
        { LAS unsigned char* d_ = L + MO_O + orow * MO_S264 + oc * 16; *(LAS u32x2*)d_ = (u32x2){stg[8].x, stg[8].y}; *(LAS u32x2*)(d_ + 8) = (u32x2){stg[8].z, stg[8].w}; \
          d_ += 32 * MO_S264; *(LAS u32x2*)d_ = (u32x2){stg[9].x, stg[9].y}; *(LAS u32x2*)(d_ + 8) = (u32x2){stg[9].z, stg[9].w}; } \
        *(LAS float*)(L + MO_SM + tid * 4) = ssm; if (tid < 2) *(LAS float*)(L + MO_SM + 2048 + tid * 4) = scm; } while (0)
    int unit = F.vcu;
    if (unit < 64 * NCHUNK) MO_LOAD(unit);
    for (; unit < 64 * NCHUNK; unit += F.G) {
        __syncthreads();
        MO_STORE();
        __syncthreads();
        if (unit + F.G < 64 * NCHUNK) MO_LOAD(unit + F.G);
        const int bh = unit / NCHUNK, j = unit % NCHUNK, b = bh >> 3, h = bh & 7;
        const int rb = ml_rowbase(b, j), trow = rb + 32 * tb + r, tt = 32 * tb + r;
        bf16x8 qf[4];
#pragma unroll
        for (int ks = 0; ks < 4; ++ks) qf[ks] = *(const LAS bf16x8*)(L + MO_Q + (32 * tb + r) * MO_S144 + (16 * ks + 8 * hh) * 2);
        f32x16 sacc[2];
#pragma unroll
        for (int kb = 0; kb < 2; ++kb) {
#pragma unroll
            for (int i = 0; i < 16; ++i) sacc[kb][i] = 0.f;
#pragma unroll
            for (int ks = 0; ks < 4; ++ks) { const bf16x8 ka = *(const LAS bf16x8*)(L + MO_K + (32 * kb + r) * MO_S144 + (16 * ks + 8 * hh) * 2); sacc[kb] = MFMA32(ka, qf[ks], sacc[kb]); }
        }
        f32x16 hsum;
#pragma unroll
        for (int i = 0; i < 16; ++i) hsum[i] = 0.f;
#pragma unroll
        for (int dir = 0; dir < 2; ++dir) {
            const float mu_t = SM[128 + dir * 64 + tt], b_t = SM[256 + dir * 64 + tt], mc = SM[512 + dir];
            const float a_t = fast_exp(mc - mu_t), e_t = fast_exp(-(b_t + mu_t));
            bf16x8 pf[2][2]; float den = 0.f;
#pragma unroll
            for (int kb = 0; kb < 2; ++kb) { f32x16 P;
#pragma unroll
                for (int g = 0; g < 4; ++g) { const int sbase = 32 * kb + 8 * g + 4 * hh; const f32x4 u4 = *(const LAS f32x4*)(SM + dir * 64 + sbase);
#pragma unroll
                    for (int ii = 0; ii < 4; ++ii) { const int sp = sbase + ii; const bool valid = dir == 0 ? (sp <= tt) : (sp >= tt);
                        const float wgt = valid ? fast_exp(u4[ii] - mu_t) : 0.f; const float p = sacc[kb][4 * g + ii] * wgt; den += p; P[4 * g + ii] = p; } }
                pf[kb][0] = pack8(P, 0); pf[kb][1] = pack8(P, 1); }
            den += shx(den, 32, lane);
            float qn = 0.f;
#pragma unroll
            for (int ks = 0; ks < 4; ++ks) { const LAS float* np = SM + 384 + dir * 64 + 16 * ks + 8 * hh; const f32x4 n0 = *(const LAS f32x4*)np, n1 = *(const LAS f32x4*)(np + 4);
                const u32x4 qq = __builtin_bit_cast(u32x4, qf[ks]);
                qn += bflo(qq.x) * n0[0] + bfhi(qq.x) * n0[1] + bflo(qq.y) * n0[2] + bfhi(qq.y) * n0[3] + bflo(qq.z) * n1[0] + bfhi(qq.z) * n1[1] + bflo(qq.w) * n1[2] + bfhi(qq.w) * n1[3]; }
            qn += shx(qn, 32, lane);
            const float denf = den + a_t * qn, inv = 1.0f / fmaxf(fabsf(denf), e_t);
            f32x16 pv, qc;
#pragma unroll
            for (int i = 0; i < 16; ++i) { pv[i] = 0.f; qc[i] = 0.f; }
            const LAS unsigned char* vtp = L + MO_V + (32 * vb + r) * MO_S136 + 8 * hh;
#pragma unroll
            for (int kb = 0; kb < 2; ++kb)
#pragma unroll
                for (int s2 = 0; s2 < 2; ++s2) { const s16x4 lo = *(const LAS s16x4*)(vtp + (32 * kb + 16 * s2) * 2), hi = *(const LAS s16x4*)(vtp + (32 * kb + 16 * s2) * 2 + 16);
                    const bf16x8 va = __builtin_shufflevector(lo, hi, 0, 1, 2, 3, 4, 5, 6, 7);
                    pv = MFMA32(va, pf[kb][s2], pv); }
            const LAS unsigned char* ctp = L + (dir == 0 ? MO_C0 : MO_C1) + (32 * vb + r) * MO_S144 + 16 * hh;
#pragma unroll
            for (int ks = 0; ks < 4; ++ks) { const bf16x8 ca = *(const LAS bf16x8*)(ctp + 32 * ks); qc = MFMA32(ca, qf[ks], qc); }
#pragma unroll
            for (int i = 0; i < 16; ++i) hsum[i] += (pv[i] + a_t * qc[i]) * inv;
        }
        float ssq = 0.f;
#pragma unroll
        for (int i = 0; i < 16; ++i) ssq += hsum[i] * hsum[i];
        ssq += shx(ssq, 32, lane);
        if (hh == 0) part[(tb * 4 + vb) * 32 + r] = ssq;
        __syncthreads();
        const float tot = part[(tb * 4 + 0) * 32 + r] + part[(tb * 4 + 1) * 32 + r] + part[(tb * 4 + 2) * 32 + r] + part[(tb * 4 + 3) * 32 + r];
        const float rstd = 1.0f / sqrtf(tot * (1.0f / 128.0f) + RMS_EPS);
#pragma unroll
        for (int g = 0; g < 4; ++g) { const int v0 = 32 * vb + 8 * g + 4 * hh;
            const u32x2 og = *(const LAS u32x2*)(L + MO_O + tt * MO_S264 + v0 * 2); const f32x4 n4 = *(const f32x4*)(ng + h * 128 + v0);
            const unsigned ov = pk_fp8x4(hsum[4 * g] * rstd * n4[0] * bflo(og.x), hsum[4 * g + 1] * rstd * n4[1] * bfhi(og.x), hsum[4 * g + 2] * rstd * n4[2] * bflo(og.y), hsum[4 * g + 3] * rstd * n4[3] * bfhi(og.y));
            *(unsigned*)(HN + (size_t)trow * 1024 + h * 128 + v0) = ov; }
    }
#undef MO_LOAD
#undef MO_G
#undef MO_STORE
}

template <class T> __device__ __forceinline__ T* launder_ptr(T* p) {
    unsigned long long v = (unsigned long long)p; unsigned lo = __builtin_amdgcn_readfirstlane((unsigned)v), hi = __builtin_amdgcn_readfirstlane((unsigned)(v >> 32));
    asm volatile("" : "+s"(lo), "+s"(hi));
    lo = __builtin_amdgcn_readfirstlane(lo); hi = __builtin_amdgcn_readfirstlane(hi);
    return (T*)(__attribute__((address_space(1))) T*)(((unsigned long long)hi << 32) | lo);
}
__device__ __forceinline__ bool phase_enter(Frame& F, bool& did, const XcdBarrier& bar, bool sync) {
    if (did && sync) { if (!MK_PER_PHASE) xcd_barrier(bar); }
    did = true;
    F.ws = launder_ptr(F.ws); F.out = launder_ptr(F.out); F.ctl = launder_ptr(F.ctl);
    int t = F.tid; asm volatile("" : "+v"(t)); F.tid = t; F.lane = t & 63; F.wave = __builtin_amdgcn_readfirstlane(t >> 6);
    return true; }
__global__ void __launch_bounds__(512, 2) mk_fwd(Args args) {
    extern __shared__ __attribute__((aligned(16))) unsigned char lds[];
    Frame F;
    F.lds = (LAS unsigned char*)lds; F.MISC = (volatile LAS int*)(F.lds + MISC_OFF);
    F.tid = threadIdx.x; F.lane = F.tid & 63; F.wave = __builtin_amdgcn_readfirstlane(F.tid >> 6);
    F.G = gridDim.x; { const int bx = blockIdx.x; F.vcu = (F.G % 8 == 0) ? (bx % 8) * (F.G / 8) + bx / 8 : bx; }
    F.ws = args.ws; F.ctl = (unsigned*)(args.ws + WS_CTL); F.out = args.out;
    for (int u = F.tid; u < (LDS_BYTES - MISC_OFF) / 4; u += 512) F.MISC[u] = 0;
    __syncthreads();
    if (F.tid < 31) { const unsigned long long pv = (unsigned long long)args.in[F.tid]; F.MISC[MI_INP + 2 * F.tid] = (int)(unsigned)pv; F.MISC[MI_INP + 2 * F.tid + 1] = (int)(unsigned)(pv >> 32); }
    __syncthreads();
    XcdBarrier bar; bar.bar = F.ctl + CW_BAR; bar.x = 0; bar.st = nullptr;
    if (!MK_PER_PHASE) bar = xcd_barrier_post(F.ctl + CW_BAR, (volatile LAS unsigned*)(F.MISC + MI_BAR));
    const int lo = args.ph_lo, hi = args.ph_hi;
    bool did = false;
#ifndef EN_MASK
#define EN_MASK 0xffffffffu
#endif
#define PHASE(id, bit) if (((EN_MASK >> (bit)) & 1u) && (id) >= lo && (id) < hi && phase_enter(F, did, bar, true))
#define PHASE_NB(id, bit) if (((EN_MASK >> (bit)) & 1u) && (id) >= lo && (id) < hi && phase_enter(F, did, bar, false))
    LAS unsigned char* ring = F.lds;
    const int bx = blockIdx.x;

    PHASE(0, 0) { phase_prologue(F); }

    for (int layer = 0; layer < 4; ++layer) {
        const int kind = layer % 3, jl = layer / 3, pb = 32 * (layer + 1);
        const bool full = layer != 3;
        const int row_lo = full ? 0 : T_CTX, pm0 = full ? 0 : 8, nM = full ? 136 : 128;
        PHASE(pb + 0, 1) {
            if (layer == 0) phase_norm<true, false, 0>(F, layer, 0, row_lo, T_ALL);
            else if (kind == 1) phase_norm<false, true, 2>(F, layer, 0, row_lo, T_ALL);
            else phase_norm<false, true, 0>(F, layer, 0, row_lo, T_ALL);
        }
        if (kind == 0) {
            PHASE(pb + 2, 2) { pg8::SchedPlain S; S.init(WSP(bf16_t, WS_H), WSP(bf16_t, WS_WCIN) + (size_t)jl * 3072 * 1024, 1024, nM, 12, F.G, bx, pm0);
                pg8::EpiConvIn E{WSP(bf16_t, WS_A0), WSP(bf16_t, WS_A1)}; pg8::gemm_phase<pg8::EpiConvIn, pg8::SchedPlain, false>(ring, S, E, F.tid); }
            PHASE(pb + 4, 3) { phase_convz(F, jl, row_lo, T_ALL); }
        } else if (kind == 1) {
            PHASE(pb + 2, 4) {
                phase_ml_scan_gates(F);
                pg8::SchedPlain S; S.init(WSP(unsigned char, WS_XP), WSP(unsigned char, WS_WMLN), 512, 136, 8, F.G, bx, 0);
                pg8::EpiMlIn E{WSP(bf16_t, WS_A0), WSP(bf16_t, WS_A0) + (size_t)T_ALL * 512, WSP(bf16_t, WS_A1)}; pg8::gemm_phase<pg8::EpiMlIn, pg8::SchedPlain, true, true>(ring, S, E, F.tid); }
            PHASE_NB(pb + 3, 18) { pg8::SchedPlain S; S.init(WSP(unsigned char, WS_WMLS), WSP(unsigned char, WS_XP), 512, 6, 136, F.G, (bx + F.G - 64) % F.G, 0);
                pg8::EpiBf16 E{WSP(bf16_t, WS_A2), T_ALL, W8_INV, 1536}; pg8::gemm_phase<pg8::EpiBf16, pg8::SchedPlain, true, true>(ring, S, E, F.tid); }
            PHASE(pb + 4, 5) { phase_ml_state(F); }
            PHASE(pb + 6, 6) { phase_ml_out(F); }
        } else {
            PHASE(pb + 2, 7) { pg8::SchedPlain S; S.init(WSP(bf16_t, WS_H), WSP(bf16_t, WS_WDN), 1024, 136, 3, F.G, bx, 0);
                pg8::EpiBf16 E{WSP(bf16_t, WS_A0), 768, 1.0f, 0}; pg8::gemm_phase<pg8::EpiBf16, pg8::SchedPlain, false>(ring, S, E, F.tid); }
            PHASE(pb + 4, 8) { phase_mla_n1(F); }
            PHASE(pb + 6, 9) { pg8::SchedPlain S; S.init(WSP(bf16_t, WS_A6), WSP(bf16_t, WS_WUQ), 384, 136, 6, F.G, bx, 0);
                pg8::EpiBf16 E{WSP(bf16_t, WS_A1), 1536, 1.0f, 0}; pg8::gemm_phase<pg8::EpiBf16, pg8::SchedPlain, false>(ring, S, E, F.tid); }
            PHASE_NB(pb + 7, 19) { pg8::SchedPlain S; S.init(WSP(bf16_t, WS_A6 + 26 * MiB), WSP(bf16_t, WS_WKN), 256, 136, 4, F.G, (bx + F.G - 48) % F.G, 0);
                pg8::EpiBf16 E{WSP(bf16_t, WS_A3), 1024, 1.0f, 0}; pg8::gemm_phase<pg8::EpiBf16, pg8::SchedPlain, false>(ring, S, E, F.tid); }
            PHASE_NB(pb + 8, 20) { pg8::SchedPlain S; S.init(WSP(bf16_t, WS_WV), WSP(bf16_t, WS_A6 + 26 * MiB), 256, 4, 136, F.G, (bx + F.G - 80) % F.G, 0);
                pg8::EpiVt8 E{WSP(unsigned char, WS_A5)}; pg8::gemm_phase<pg8::EpiVt8, pg8::SchedPlain, false>(ring, S, E, F.tid); }
            PHASE(pb + 9, 10) { phase_mla_n2(F); }
            PHASE(pb + 10, 11) { phase_attn(F); }
        }
        PHASE(pb + 12, 12) {
            const unsigned char* mixA = kind == 0 ? WSP(unsigned char, WS_A2) : (kind == 1 ? WSP(unsigned char, WS_A3) : WSP(unsigned char, WS_A6 + 50 * MiB));
            const unsigned char* mixW = kind == 0 ? WSP(unsigned char, WS_WCOUT) + (size_t)jl * 1024 * 1024 : (kind == 1 ? WSP(unsigned char, WS_WMLO) : WSP(unsigned char, WS_WMO));
            pg8::SchedPlain S; S.init(mixA, mixW, 512, nM, 4, F.G, bx, pm0);
            const float* sc = layer == 0 ? inp(F, IN_CTX) : nullptr; const float* sl = layer == 0 ? inp(F, IN_X) : nullptr;
            pg8::EpiResid E{sc, sl, WSP(bf16_t, WS_XB), WSP(float, WS_MOD) + (size_t)layer * 9 * 6144 + 2 * 1024};
            pg8::gemm_phase<pg8::EpiResid, pg8::SchedPlain, true, true>(ring, S, E, F.tid);
        }
        PHASE(pb + 14, 13) { phase_norm<false, false, 1>(F, layer, 1, row_lo, T_ALL); }
        PHASE(pb + 18, 15) {
            moe_tables(F, layer, true);
            pg8::SchedMoe S; S.A = (const char*)WSP(unsigned char, WS_XP); S.W = (const char*)(WSP(unsigned char, WS_W1) + (size_t)layer * 32 * 2048 * 1024); S.wstride = (size_t)2048 * 1024;
            S.K = 512; S.NT = 8; S.nunits = __builtin_amdgcn_readfirstlane(F.MISC[MI_PPRE + NEXP]) * 8; S.G = F.G; S.c = bx; S.ppre = (const LAS int*)(F.MISC + MI_PPRE); S.ecnt = (const LAS int*)(F.MISC + MI_CNT); S.list = WSP(int, WS_LIST); S.prep();
            pg8::EpiMoe1 E{WSP(unsigned char, WS_ACT), inp(F, IN_MOE_B1) + (size_t)layer * 32 * 2048};
            pg8::gemm_phase<pg8::EpiMoe1, pg8::SchedMoe, true, true>(ring, S, E, F.tid);
        }
        PHASE(pb + 20, 16) {
            moe_tables(F, layer, true);
            pg8::SchedMoe S; S.A = (const char*)WSP(unsigned char, WS_ACT); S.W = (const char*)(WSP(unsigned char, WS_W2) + (size_t)layer * 32 * 1024 * 1024); S.wstride = (size_t)1024 * 1024;
            S.K = 512; S.NT = 4; S.nunits = __builtin_amdgcn_readfirstlane(F.MISC[MI_PPRE + NEXP]) * 4; S.G = F.G; S.c = bx; S.ppre = (const LAS int*)(F.MISC + MI_PPRE); S.ecnt = (const LAS int*)(F.MISC + MI_CNT); S.list = nullptr; S.prep();
            pg8::EpiMoe2 E{WSP(unsigned char, WS_Y), inp(F, IN_MOE_B2) + (size_t)layer * 32 * 1024};
            pg8::gemm_phase<pg8::EpiMoe2, pg8::SchedMoe, true, true>(ring, S, E, F.tid);
        }
    }
    PHASE(1000, 17) { phase_final(F, 3); }
#undef PHASE
}

extern "C" void kernel_launch(void* const* d_in, const int* in_sizes, int n_in, void* d_out, int out_size, void* d_ws, size_t ws_size, hipStream_t stream) {
    static int grid = 0;
    if (grid == 0) {
        if (n_in != 31 || out_size != T_LAT * D || ws_size < WS_END) { fprintf(stderr, "kernel_launch: unexpected shapes (n_in %d out %d ws %zu)\n", n_in, out_size, ws_size); grid = -1; return; }
        int dev = 0, cus = 0;
        if (hipGetDevice(&dev) != hipSuccess || hipDeviceGetAttribute(&cus, hipDeviceAttributeMultiprocessorCount, dev) != hipSuccess) { grid = -1; return; }
        if (hipFuncSetAttribute((const void*)mk_fwd, hipFuncAttributeMaxDynamicSharedMemorySize, LDS_BYTES) != hipSuccess) { fprintf(stderr, "kernel_launch: hipFuncSetAttribute failed\n"); grid = -1; return; }
        int per_cu = 0;
        if (hipOccupancyMaxActiveBlocksPerMultiprocessor(&per_cu, (const void*)mk_fwd, 512, LDS_BYTES) != hipSuccess || per_cu < 1) fprintf(stderr, "kernel_launch: occupancy query says %d\n", per_cu);
        (void)hipGetLastError();
        grid = cus;
    }
    if (grid < 0) return;
    (void)hipMemsetAsync((char*)d_ws + WS_CTL, 0, CTL_ZERO_BYTES, stream);
    Args a{};
    for (int i = 0; i < 31; ++i) a.in[i] = (const float*)d_in[i];
    a.out = (float*)d_out; a.ws = (unsigned char*)d_ws;
#if MK_PER_PHASE
    static const int conv_ph[] = {0, 2, 4, 12, 14, 18, 20}, ml_ph[] = {0, 2, 3, 4, 6, 12, 14, 18, 20}, mla_ph[] = {0, 2, 4, 6, 7, 8, 9, 10, 12, 14, 18, 20};
    int ids[64]; int n = 0; ids[n++] = 0;
    for (int layer = 0; layer < 4; ++layer) { const int kind = layer % 3, pb = 32 * (layer + 1);
        if (kind == 0) for (int k : conv_ph) ids[n++] = pb + k; else if (kind == 1) for (int k : ml_ph) ids[n++] = pb + k; else for (int k : mla_ph) ids[n++] = pb + k; }
    ids[n++] = 1000;
#ifndef PROBE_IDS
#define PROBE_IDS
#endif
    static const int probe_ids[] = {-1, PROBE_IDS};
    for (int i = 0; i < n; ++i) { int reps = 1; for (int p : probe_ids) if (p == ids[i]) ++reps;
        for (int q = 0; q < reps; ++q) { a.ph_lo = ids[i]; a.ph_hi = ids[i] + 1; hipLaunchKernelGGL(mk_fwd, dim3(grid), dim3(512), LDS_BYTES, stream, a); } }
#else
    a.ph_lo = 0; a.ph_hi = 100000;
    hipLaunchKernelGGL(mk_fwd, dim3(grid), dim3(512), LDS_BYTES, stream, a);
#endif
}
```

```cpp
#include <hip/hip_runtime.h>
#include <cstdio>
#include <cstdint>

#ifndef MK_PER_PHASE
#define MK_PER_PHASE 0
#endif

#define LAS __attribute__((address_space(3)))
typedef unsigned short bf16_t;
typedef short bf16x8 __attribute__((ext_vector_type(8)));
typedef short s16x4 __attribute__((ext_vector_type(4)));
typedef float f32x4 __attribute__((ext_vector_type(4)));
typedef float f32x2 __attribute__((ext_vector_type(2)));
typedef float f32x16 __attribute__((ext_vector_type(16)));
typedef unsigned u32x4 __attribute__((ext_vector_type(4)));
typedef unsigned u32x2 __attribute__((ext_vector_type(2)));

constexpr int D = 1024, NB = 8, SEQ = 4096, CTXL = 256;
constexpr int T_CTX = NB * CTXL, T_LAT = NB * SEQ, T_ALL = T_CTX + T_LAT;
constexpr int NEXP = 32;
constexpr int MOE_ROWS_MAX = T_ALL * 4 + NEXP * 256;
constexpr float RMS_EPS = 1e-6f;
constexpr int NCHUNK = 68;

__device__ __forceinline__ unsigned cvt_pk_bf16(float lo, float hi) { unsigned r; asm volatile("v_cvt_pk_bf16_f32 %0, %1, %2" : "=v"(r) : "v"(lo), "v"(hi)); return r; }
__device__ __forceinline__ float bflo(unsigned u) { return __uint_as_float(u << 16); }
__device__ __forceinline__ float bfhi(unsigned u) { return __uint_as_float(u & 0xffff0000u); }
__device__ __forceinline__ float bf1(bf16_t b) { return __uint_as_float(((unsigned)b) << 16); }
__device__ __forceinline__ bf16_t f2bf(float f) { return (bf16_t)(cvt_pk_bf16(f, 0.f) & 0xffffu); }
__device__ __forceinline__ float shx(float v, int o, int lane) { return __int_as_float(__builtin_amdgcn_ds_bpermute((lane ^ o) << 2, __float_as_int(v))); }
__device__ __forceinline__ int shxi(int v, int o, int lane) { return __builtin_amdgcn_ds_bpermute((lane ^ o) << 2, v); }
__device__ __forceinline__ float xsum16(float v) { const auto r = __builtin_amdgcn_permlane16_swap(__float_as_uint(v), __float_as_uint(v), false, false); return __uint_as_float(r[0]) + __uint_as_float(r[1]); }
__device__ __forceinline__ float xsum32(float v) { const auto r = __builtin_amdgcn_permlane32_swap(__float_as_uint(v), __float_as_uint(v), false, false); return __uint_as_float(r[0]) + __uint_as_float(r[1]); }
__device__ __forceinline__ float xmax32(float v) { const auto r = __builtin_amdgcn_permlane32_swap(__float_as_uint(v), __float_as_uint(v), false, false); return fmaxf(__uint_as_float(r[0]), __uint_as_float(r[1])); }
__device__ __forceinline__ void xbest16(float& v, int& i) { const auto rv = __builtin_amdgcn_permlane16_swap(__float_as_uint(v), __float_as_uint(v), false, false); const auto ri = __builtin_amdgcn_permlane16_swap((unsigned)i, (unsigned)i, false, false);
    const float a = __uint_as_float(rv[0]), b = __uint_as_float(rv[1]); const int ia = (int)ri[0], ib = (int)ri[1]; const bool tb = (b > a) || (b == a && ib < ia); v = tb ? b : a; i = tb ? ib : ia; }
__device__ __forceinline__ void xbest32(float& v, int& i) { const auto rv = __builtin_amdgcn_permlane32_swap(__float_as_uint(v), __float_as_uint(v), false, false); const auto ri = __builtin_amdgcn_permlane32_swap((unsigned)i, (unsigned)i, false, false);
    const float a = __uint_as_float(rv[0]), b = __uint_as_float(rv[1]); const int ia = (int)ri[0], ib = (int)ri[1]; const bool tb = (b > a) || (b == a && ib < ia); v = tb ? b : a; i = tb ? ib : ia; }
__device__ __forceinline__ float shup(float v, int o, int lane) { return __int_as_float(__builtin_amdgcn_ds_bpermute((lane - o) << 2, __float_as_int(v))); }
__device__ __forceinline__ float wave_sum(float v, int lane) {
#pragma unroll
    for (int o = 1; o < 64; o <<= 1) v += shx(v, o, lane);
    return v;
}
__device__ __forceinline__ float fast_exp(float x) { return __builtin_amdgcn_exp2f(x * 1.44269504088896f); }
__device__ __forceinline__ float fast_rcp(float x) { return __builtin_amdgcn_rcpf(x); }
__device__ __forceinline__ float sigmoidf_(float x) { return fast_rcp(1.0f + fast_exp(-x)); }
#define MFMA32(a, b, c) __builtin_amdgcn_mfma_f32_32x32x16_bf16((a), (b), (c), 0, 0, 0)
#define MFMA16(a, b, c) __builtin_amdgcn_mfma_f32_16x16x32_bf16((a), (b), (c), 0, 0, 0)
__device__ __forceinline__ bf16x8 pack8(const f32x16& x, int s) {
    u32x4 p;
    p[0] = cvt_pk_bf16(x[8 * s + 0], x[8 * s + 1]); p[1] = cvt_pk_bf16(x[8 * s + 2], x[8 * s + 3]);
    p[2] = cvt_pk_bf16(x[8 * s + 4], x[8 * s + 5]); p[3] = cvt_pk_bf16(x[8 * s + 6], x[8 * s + 7]);
    return __builtin_bit_cast(bf16x8, p);
}

typedef int v8i __attribute__((ext_vector_type(8)));
__device__ __forceinline__ v8i cat8(bf16x8 a, bf16x8 b) { const u32x4 x = __builtin_bit_cast(u32x4, a), y = __builtin_bit_cast(u32x4, b); return (v8i){(int)x.x, (int)x.y, (int)x.z, (int)x.w, (int)y.x, (int)y.y, (int)y.z, (int)y.w}; }
__device__ __forceinline__ unsigned pk_fp8x4(float a, float b, float c, float d) { int p = 0; p = __builtin_amdgcn_cvt_pk_fp8_f32(a, b, p, false); p = __builtin_amdgcn_cvt_pk_fp8_f32(c, d, p, true); return (unsigned)p; }
constexpr float W8_SCALE = 64.0f, W8_INV = 1.0f / 64.0f;
template <bool F8> struct FragSel { typedef v8i A; };
__device__ __forceinline__ bf16x8 half8(const v8i& v, int k) { const u32x4 t = k ? (u32x4){(unsigned)v[4], (unsigned)v[5], (unsigned)v[6], (unsigned)v[7]} : (u32x4){(unsigned)v[0], (unsigned)v[1], (unsigned)v[2], (unsigned)v[3]}; return __builtin_bit_cast(bf16x8, t); }
namespace pg8 {
constexpr int BM = 256, BK = 64, HALF = 128, HTB = HALF * BK * 2, STAGE_BYTES = 8 * HTB, NXCD = 8, WGM = 8;
__host__ __device__ __forceinline__ int lds_byte(int r, int c) { const int st = (r >> 4) * 2 + (c >> 5), rr = r & 15, cc = c & 31, ob = rr * 64 + cc * 2; return st * 1024 + (ob ^ (((ob >> 9) & 1) << 5)); }
__host__ __device__ __forceinline__ void stage_rc(int b, int& R, int& C) { const int st = b / 1024, sb = b % 1024, swz = sb ^ (((sb >> 9) & 1) << 5); R = (st >> 1) * 16 + swz / 64; C = (st & 1) * 32 + (swz % 64) / 2; }
__host__ __device__ __forceinline__ int perm32(int rho) { const int n = rho >> 4, i = rho & 15; return 8 * (i >> 2) + 4 * n + (i & 3); }

struct Unit { int pm, pn, e; };

struct SchedPlain {
    const char* A; const char* B; int K; int nM, nN, nwg, G, c, pm0; unsigned mnig;
    __device__ __forceinline__ void init(const void* A_, const void* B_, int K_, int nM_, int nN_, int G_, int c_, int pm0_) { A = (const char*)A_; B = (const char*)B_; K = K_; nM = nM_; nN = nN_; nwg = nM * nN; G = G_; c = c_; pm0 = pm0_;
        mnig = (unsigned)((0x100000000ull + (unsigned)(WGM * nN) - 1u) / (unsigned)(WGM * nN)); }
    __device__ __forceinline__ bool next(int i, Unit& u) const {
        const long L = (long)i * G + c; if (L >= nwg) return false;
        int wgid = (int)L; { const int q = nwg / NXCD, r = nwg % NXCD, xcd = wgid % NXCD, off = wgid / NXCD; wgid = (xcd < r ? xcd * (q + 1) : r * (q + 1) + (xcd - r) * q) + off; }
        const int nig = WGM * nN, gid = (int)(((unsigned long long)(unsigned)wgid * mnig) >> 32), rem = wgid - gid * nig, fm = gid * WGM, gsz = (nM - fm) < WGM ? (nM - fm) : WGM;
        if (gsz == WGM) { u.pm = pm0 + fm + (rem & (WGM - 1)); u.pn = rem >> 3; } else { u.pm = pm0 + fm + rem % gsz; u.pn = rem / gsz; }
        u.e = 0; return true;
    }
    __device__ __forceinline__ const char* a_base(const Unit& u) const { return A + (size_t)u.pm * (size_t)(BM * 2) * K; }
    __device__ __forceinline__ const char* b_base(const Unit& u) const { return B + (size_t)u.pn * (size_t)(BM * 2) * K; }
    __device__ __forceinline__ void tok_off(const Unit& u, const int (&R)[2], const unsigned (&coff)[2], unsigned (&o)[2][2]) const {
#pragma unroll
        for (int h = 0; h < 2; ++h)
#pragma unroll
            for (int i = 0; i < 2; ++i) o[h][i] = (unsigned)(u.pm * 256 + h * 128 + R[i]) * (unsigned)(K * 2) + coff[i];
    }
};
constexpr int MI_PEXP_REL = 1152 - 16;
struct SchedMoe {
    const char* A; const char* W; size_t wstride; int K, NT, nunits, G, c; const LAS int* ppre; const LAS int* ecnt; const int* list;
    int xa, jq, jr, ppx;
    __device__ __forceinline__ void prep() {
        if ((G & 7) == 0 && ((G >> 3) % NT) == 0) { const int j = c >> 3; xa = c & 7; ppx = (G >> 3) / NT; jq = j / NT; jr = j % NT; } else { xa = 0; jq = 0; jr = 0; ppx = 0; }
    }
    __device__ __forceinline__ bool next(int i, Unit& u) const {
        int p, pn;
        if (ppx != 0) {
            p = (i * 8 + xa) * ppx + jq; pn = jr;
            if (p * NT >= nunits) return false;
        } else {
            const long L = (long)i * G + c; if (L >= nunits) return false;
            p = (int)(L / NT); pn = (int)(L % NT);
        }
        u.pm = p; u.pn = pn;
        u.e = __builtin_amdgcn_readfirstlane(ppre[MI_PEXP_REL + p]); return true;
    }
    __device__ __forceinline__ const char* a_base(const Unit& u) const { return A + (size_t)u.pm * (size_t)(BM * 2) * K; }
    __device__ __forceinline__ const char* b_base(const Unit& u) const { return W + (size_t)u.e * wstride + (size_t)u.pn * (size_t)(BM * 2) * K; }
    __device__ __forceinline__ void tok_off(const Unit& u, const int (&R)[2], const unsigned (&coff)[2], unsigned (&o)[2][2]) const {
        if (list == nullptr) {
#pragma unroll
            for (int h = 0; h < 2; ++h)
#pragma unroll
                for (int i = 0; i < 2; ++i) o[h][i] = (unsigned)(u.pm * 256 + h * 128 + R[i]) * (unsigned)(K * 2) + coff[i];
            return;
        }
        const int base = (u.pm - __builtin_amdgcn_readfirstlane(ppre[u.e])) * 256, cn = __builtin_amdgcn_readfirstlane(ecnt[u.e]); const int* lp = list + (size_t)u.e * T_ALL;
#pragma unroll
        for (int h = 0; h < 2; ++h)
#pragma unroll
            for (int i = 0; i < 2; ++i) { const int pos = base + h * 128 + R[i]; o[h][i] = (unsigned)lp[pos < cn ? pos : 0] * (unsigned)(K * 2) + coff[i]; }
    }
};

struct EpiF32 {
    static constexpr bool PERM = false;
    float* C; int ldc;
    __device__ __forceinline__ void operator()(const f32x4 (&acc)[2][2][4][2], const Unit& u, int wr, int wc, int fr, int fq) const {
        const int row0 = u.pm * BM + wr * 64 + fr, col0 = u.pn * BM + wc * 32 + 4 * fq;
#pragma unroll
        for (int ai = 0; ai < 2; ++ai)
#pragma unroll
            for (int m = 0; m < 4; ++m) { float* rowp = C + (size_t)(row0 + ai * HALF + m * 16) * ldc + col0;
#pragma unroll
                for (int bj = 0; bj < 2; ++bj)
#pragma unroll
                    for (int n = 0; n < 2; ++n) *(f32x4*)(rowp + bj * HALF + n * 16) = acc[ai][bj][m][n]; }
    }
};
struct EpiBf16 {
    static constexpr bool PERM = true;
    bf16_t* O; int ldc; float scale; int blk_nf;
    __device__ __forceinline__ void operator()(const f32x4 (&acc)[2][2][4][2], const Unit& u, int wr, int wc, int fr, int fq) const {
        const int row0 = u.pm * BM + wr * 64 + fr, col0 = u.pn * BM + wc * 32 + 8 * fq;
#pragma unroll
        for (int ai = 0; ai < 2; ++ai)
#pragma unroll
            for (int m = 0; m < 4; ++m) { const int row = row0 + ai * HALF + m * 16;
#pragma unroll
                for (int bj = 0; bj < 2; ++bj) { const f32x4 v0 = acc[ai][bj][m][0] * scale, v1 = acc[ai][bj][m][1] * scale; const int col = col0 + bj * HALF;
                    u32x4 w; w.x = cvt_pk_bf16(v0[0], v0[1]); w.y = cvt_pk_bf16(v0[2], v0[3]); w.z = cvt_pk_bf16(v1[0], v1[1]); w.w = cvt_pk_bf16(v1[2], v1[3]);
                    bf16_t* p = blk_nf ? O + ((size_t)(col >> 6) * blk_nf + row) * 64 + (col & 63) : O + (size_t)row * ldc + col;
                    *(u32x4*)p = w; } }
    }
};
struct EpiVt8 {
    static constexpr bool PERM = true;
    unsigned char* O;
    __device__ __forceinline__ void operator()(const f32x4 (&acc)[2][2][4][2], const Unit& u, int wr, int wc, int fr, int fq) const {
        const int row0 = u.pm * BM + wr * 64 + fr, col0 = u.pn * BM + wc * 32 + 8 * fq;
#pragma unroll
        for (int ai = 0; ai < 2; ++ai)
#pragma unroll
            for (int m = 0; m < 4; ++m) { const int row = row0 + ai * HALF + m * 16;
#pragma unroll
                for (int bj = 0; bj < 2; ++bj) { const f32x4 v0 = acc[ai][bj][m][0], v1 = acc[ai][bj][m][1]; const int col = col0 + bj * HALF, kap = col & 63;
                    unsigned char* p = O + ((size_t)(col >> 6) * 1024 + row) * 64 + 16 * (kap >> 5) + 4 * ((kap & 31) >> 3);
                    *(unsigned*)p = pk_fp8x4(__builtin_amdgcn_fmed3f(v0[0], -448.f, 448.f), __builtin_amdgcn_fmed3f(v0[1], -448.f, 448.f), __builtin_amdgcn_fmed3f(v0[2], -448.f, 448.f), __builtin_amdgcn_fmed3f(v0[3], -448.f, 448.f));
                    *(unsigned*)(p + 32) = pk_fp8x4(__builtin_amdgcn_fmed3f(v1[0], -448.f, 448.f), __builtin_amdgcn_fmed3f(v1[1], -448.f, 448.f), __builtin_amdgcn_fmed3f(v1[2], -448.f, 448.f), __builtin_amdgcn_fmed3f(v1[3], -448.f, 448.f)); } }
    }
};
struct EpiConvIn {
    static constexpr bool PERM = true;
    bf16_t* BG; bf16_t* V;
    __device__ __forceinline__ void operator()(const f32x4 (&acc)[2][2][4][2], const Unit& u, int wr, int wc, int fr, int fq) const {
        const int row0 = u.pm * BM + wr * 64 + fr;
        if (u.pn < 4) {
            const int col0 = u.pn * BM + wc * 32 + 8 * fq;
#pragma unroll
            for (int ai = 0; ai < 2; ++ai)
#pragma unroll
                for (int m = 0; m < 4; ++m) { bf16_t* rowp = BG + (size_t)(row0 + ai * HALF + m * 16) * D + col0;
#pragma unroll
                    for (int bj = 0; bj < 2; ++bj) { const f32x4 v0 = acc[ai][bj][m][0], v1 = acc[ai][bj][m][1];
                        u32x4 w; w.x = cvt_pk_bf16(v0[0], v0[1]); w.y = cvt_pk_bf16(v0[2], v0[3]); w.z = cvt_pk_bf16(v1[0], v1[1]); w.w = cvt_pk_bf16(v1[2], v1[3]);
                        *(u32x4*)(rowp + bj * HALF) = w; } }
        } else {
            const int ch0 = (u.pn - 4) * HALF + wc * 32 + 8 * fq;
#pragma unroll
            for (int ai = 0; ai < 2; ++ai)
#pragma unroll
                for (int m = 0; m < 4; ++m) { bf16_t* rowp = V + (size_t)(row0 + ai * HALF + m * 16) * D + ch0;
                    const f32x4 v0 = acc[ai][0][m][0] * acc[ai][1][m][0], v1 = acc[ai][0][m][1] * acc[ai][1][m][1];
                    u32x4 w; w.x = cvt_pk_bf16(v0[0], v0[1]); w.y = cvt_pk_bf16(v0[2], v0[3]); w.z = cvt_pk_bf16(v1[0], v1[1]); w.w = cvt_pk_bf16(v1[2], v1[3]);
                    *(u32x4*)(rowp) = w; }
        }
    }
};
struct EpiMlIn {
    static constexpr bool PERM = true;
    bf16_t* Q; bf16_t* Kb; bf16_t* O;
    __device__ __forceinline__ void operator()(const f32x4 (&acc)[2][2][4][2], const Unit& u, int wr, int wc, int fr, int fq) const {
        const int row0 = u.pm * BM + wr * 64 + fr, cw = wc * 32 + 8 * fq;
        bf16_t* base; int ldc; int mode;
        if (u.pn < 2) { base = Q + u.pn * BM + cw; ldc = 512; mode = 0; }
        else if (u.pn < 4) { base = Kb + (u.pn - 2) * BM + cw; ldc = 512; mode = 1; }
        else { base = O + (u.pn - 4) * BM + cw; ldc = 1024; mode = 2; }
#pragma unroll
        for (int ai = 0; ai < 2; ++ai)
#pragma unroll
            for (int m = 0; m < 4; ++m) { bf16_t* rowp = base + (size_t)(row0 + ai * HALF + m * 16) * ldc;
#pragma unroll
                for (int bj = 0; bj < 2; ++bj) { f32x4 v0 = acc[ai][bj][m][0], v1 = acc[ai][bj][m][1];
                    { const float sc = mode == 0 ? 0.125f * W8_INV : W8_INV; v0 = v0 * sc; v1 = v1 * sc; }
                    if (mode == 2) {
#pragma unroll
                        for (int j = 0; j < 4; ++j) { v0[j] = sigmoidf_(v0[j]); v1[j] = sigmoidf_(v1[j]); } }
                    u32x4 w; w.x = cvt_pk_bf16(v0[0], v0[1]); w.y = cvt_pk_bf16(v0[2], v0[3]); w.z = cvt_pk_bf16(v1[0], v1[1]); w.w = cvt_pk_bf16(v1[2], v1[3]);
                    *(u32x4*)(rowp + bj * HALF) = w; } }
    }
};
struct EpiResid {
    static constexpr bool PERM = true;
    const float* src_c; const float* src_l;
    bf16_t* X; const float* g;
    __device__ __forceinline__ void operator()(const f32x4 (&acc)[2][2][4][2], const Unit& u, int wr, int wc, int fr, int fq) const {
        const bool isctx = u.pm < 8;
        const int b9 = isctx ? 8 : ((u.pm - 8) >> 4);
        const int col0 = u.pn * BM + wc * 32 + 8 * fq;
        const float* gp = g + (size_t)b9 * 6144 + col0;
        f32x4 gv[2][2];
#pragma unroll
        for (int bj = 0; bj < 2; ++bj)
#pragma unroll
            for (int n = 0; n < 2; ++n) gv[bj][n] = *(const f32x4*)(gp + bj * HALF + 4 * n) * W8_INV;
        bf16_t* xp = X + (size_t)u.pm * BM * D + col0;
        if (src_l != nullptr) {
            const float* sp = (isctx ? src_c + (size_t)u.pm * BM * D : src_l + (size_t)(u.pm - 8) * BM * D) + col0;
#pragma unroll
            for (int ai = 0; ai < 2; ++ai)
#pragma unroll
                for (int m = 0; m < 4; ++m) { const size_t off = (size_t)(wr * 64 + ai * HALF + m * 16 + fr) * D;
#pragma unroll
                    for (int bj = 0; bj < 2; ++bj) { const f32x4 x0 = *(const f32x4*)(sp + off + bj * HALF), x1 = *(const f32x4*)(sp + off + bj * HALF + 4);
                        const f32x4 v0 = x0 + gv[bj][0] * acc[ai][bj][m][0], v1 = x1 + gv[bj][1] * acc[ai][bj][m][1];
                        u32x4 w; w.x = cvt_pk_bf16(v0[0], v0[1]); w.y = cvt_pk_bf16(v0[2], v0[3]); w.z = cvt_pk_bf16(v1[0], v1[1]); w.w = cvt_pk_bf16(v1[2], v1[3]);
                        *(u32x4*)(xp + off + bj * HALF) = w; } }
        } else {
#pragma unroll
            for (int ai = 0; ai < 2; ++ai) {
                u32x4 xs[4][2];
#pragma unroll
                for (int m = 0; m < 4; ++m) { const size_t off = (size_t)(wr * 64 + ai * HALF + m * 16 + fr) * D;
#pragma unroll
                    for (int bj = 0; bj < 2; ++bj) xs[m][bj] = *(const u32x4*)(xp + off + bj * HALF); }
                asm volatile("" ::: "memory");
#pragma unroll
                for (int m = 0; m < 4; ++m) { const size_t off = (size_t)(wr * 64 + ai * HALF + m * 16 + fr) * D;
#pragma unroll
                    for (int bj = 0; bj < 2; ++bj) { const u32x4 xv = xs[m][bj]; const f32x4 a0 = acc[ai][bj][m][0], a1 = acc[ai][bj][m][1];
                        u32x4 w;
                        w.x = cvt_pk_bf16(bflo(xv.x) + gv[bj][0][0] * a0[0], bfhi(xv.x) + gv[bj][0][1] * a0[1]); w.y = cvt_pk_bf16(bflo(xv.y) + gv[bj][0][2] * a0[2], bfhi(xv.y) + gv[bj][0][3] * a0[3]);
                        w.z = cvt_pk_bf16(bflo(xv.z) + gv[bj][1][0] * a1[0], bfhi(xv.z) + gv[bj][1][1] * a1[1]); w.w = cvt_pk_bf16(bflo(xv.w) + gv[bj][1][2] * a1[2], bfhi(xv.w) + gv[bj][1][3] * a1[3]);
                        *(u32x4*)(xp + off + bj * HALF) = w; } }
                asm volatile("" ::: "memory");
            }
        }
    }
};
struct EpiMoe1 {
    static constexpr bool PERM = true;
    unsigned char* ACT; const float* b1;
    static __device__ __forceinline__ f32x2 act2(f32x2 ag, f32x2 al, f32x2 bg, f32x2 bl1) {
        const f32x2 g = ag * W8_INV + bg, l1 = al * W8_INV + bl1;
        f32x2 a, b; a.x = fminf(g.x, 7.0f); a.y = fminf(g.y, 7.0f); b.x = __builtin_amdgcn_fmed3f(l1.x, -6.0f, 8.0f); b.y = __builtin_amdgcn_fmed3f(l1.y, -6.0f, 8.0f);
        const f32x2 t = a * (-1.702f * 1.44269504088896f);
        f32x2 e; e.x = __builtin_amdgcn_exp2f(t.x); e.y = __builtin_amdgcn_exp2f(t.y);
        const f32x2 d = e + 1.0f; f32x2 s; s.x = __builtin_amdgcn_rcpf(d.x); s.y = __builtin_amdgcn_rcpf(d.y);
        return (a * b) * s;
    }
    __device__ __forceinline__ void operator()(const f32x4 (&acc)[2][2][4][2], const Unit& u, int wr, int wc, int fr, int fq) const {
        const int row0 = u.pm * BM + wr * 64 + fr, ch0 = u.pn * HALF + wc * 32 + 8 * fq;
        const float* bp = b1 + (size_t)u.e * 2048 + ch0;
        const f32x4 bg0 = *(const f32x4*)(bp), bg1 = *(const f32x4*)(bp + 4), bl0 = *(const f32x4*)(bp + 1024) + 1.0f, bl1 = *(const f32x4*)(bp + 1028) + 1.0f;
#pragma unroll
        for (int ai = 0; ai < 2; ++ai)
#pragma unroll
            for (int m = 0; m < 4; ++m) { unsigned char* rowp = ACT + (size_t)(row0 + ai * HALF + m * 16) * D + ch0;
                const f32x4 g0 = acc[ai][0][m][0], g1 = acc[ai][0][m][1], l0 = acc[ai][1][m][0], l1 = acc[ai][1][m][1];
                const f32x2 r0 = act2((f32x2){g0[0], g0[1]}, (f32x2){l0[0], l0[1]}, (f32x2){bg0[0], bg0[1]}, (f32x2){bl0[0], bl0[1]});
                const f32x2 r1 = act2((f32x2){g0[2], g0[3]}, (f32x2){l0[2], l0[3]}, (f32x2){bg0[2], bg0[3]}, (f32x2){bl0[2], bl0[3]});
                const f32x2 r2 = act2((f32x2){g1[0], g1[1]}, (f32x2){l1[0], l1[1]}, (f32x2){bg1[0], bg1[1]}, (f32x2){bl1[0], bl1[1]});
                const f32x2 r3 = act2((f32x2){g1[2], g1[3]}, (f32x2){l1[2], l1[3]}, (f32x2){bg1[2], bg1[3]}, (f32x2){bl1[2], bl1[3]});
                u32x2 w; w.x = pk_fp8x4(r0.x, r0.y, r1.x, r1.y); w.y = pk_fp8x4(r2.x, r2.y, r3.x, r3.y);
                *(u32x2*)(rowp) = w; }
    }
};
struct EpiMoe2 {
    static constexpr bool PERM = true;
    unsigned char* Y; const float* b2;
    __device__ __forceinline__ void operator()(const f32x4 (&acc)[2][2][4][2], const Unit& u, int wr, int wc, int fr, int fq) const {
        const int row0 = u.pm * BM + wr * 64 + fr, col0 = u.pn * BM + wc * 32 + 8 * fq;
        const float* bp = b2 + (size_t)u.e * 1024 + col0;
        f32x4 bv[2][2];
#pragma unroll
        for (int bj = 0; bj < 2; ++bj)
#pragma unroll
            for (int n = 0; n < 2; ++n) bv[bj][n] = *(const f32x4*)(bp + bj * HALF + 4 * n);
#pragma unroll
        for (int ai = 0; ai < 2; ++ai)
#pragma unroll
            for (int m = 0; m < 4; ++m) { unsigned char* rowp = Y + (size_t)(row0 + ai * HALF + m * 16) * D + col0;
#pragma unroll
                for (int bj = 0; bj < 2; ++bj) { const f32x4 v0 = acc[ai][bj][m][0] * W8_INV + bv[bj][0], v1 = acc[ai][bj][m][1] * W8_INV + bv[bj][1];
                    f32x4 c0, c1;
#pragma unroll
                    for (int j = 0; j < 4; ++j) { c0[j] = __builtin_amdgcn_fmed3f(v0[j], -448.f, 448.f); c1[j] = __builtin_amdgcn_fmed3f(v1[j], -448.f, 448.f); }
                    u32x2 w; w.x = pk_fp8x4(c0[0], c0[1], c0[2], c0[3]); w.y = pk_fp8x4(c1[0], c1[1], c1[2], c1[3]);
                    *(u32x2*)(rowp + bj * HALF) = w; } }
    }
};

template <class Epi, class Sched, bool GATHER, bool FP8 = false>
__device__ __forceinline__ void gemm_phase(LAS unsigned char* lds, const Sched& S, const Epi& E, const int tid) {
    const int wid = __builtin_amdgcn_readfirstlane(tid >> 6), lane = tid & 63, wr = wid >> 2, wc = wid & 3, fr = lane & 15, fq = lane >> 4;
    const int K = S.K, nt = K / BK;
    unsigned voffA[2], voffB[2]; int Rrow[2]; unsigned coffA[2];
#pragma unroll
    for (int i = 0; i < 2; ++i) { int R, C; stage_rc(tid * 16 + i * 8192, R, C); const int Rb = Epi::PERM ? ((R & ~31) + perm32(R & 31)) : R;
        voffA[i] = (unsigned)(R * K + C) * 2u; voffB[i] = (unsigned)(Rb * K + C) * 2u; Rrow[i] = R; coffA[i] = (unsigned)C * 2u; }
    const size_t kstep = (size_t)(BK * 2);
    const size_t hstep = (size_t)HALF * K * 2;
    const unsigned ldsw = (unsigned)wid * 1024u;
    const int aoff = lds_byte(wr * 64 + fr, fq * 8), boff = lds_byte(wc * 32 + fr, fq * 8);
#define PG8_SA(b, h) (((b) * 2 + (h)) * HTB)
#define PG8_SB(b, h) ((4 + (b) * 2 + (h)) * HTB)
#define PG8_STAGE(bufoff, gbase, voff) do { _Pragma("unroll") for (int _i = 0; _i < 2; ++_i) \
        __builtin_amdgcn_global_load_lds((const unsigned*)((const char*)(gbase) + (size_t)(voff)[_i]), (LAS unsigned*)(lds + (bufoff) + ldsw + _i * 8192), 16, 0, 0); } while (0)
#define PG8_STAGE_G(bufoff, offs, kb) do { _Pragma("unroll") for (int _i = 0; _i < 2; ++_i) \
        __builtin_amdgcn_global_load_lds((const unsigned*)(gA + (size_t)((offs)[_i] + (unsigned)(kb))), (LAS unsigned*)(lds + (bufoff) + ldsw + _i * 8192), 16, 0, 0); } while (0)
#define PG8_LDA(dst, b, h) do { _Pragma("unroll") for (int m = 0; m < 4; ++m) { const u32x4 lo_ = *(const LAS u32x4*)(lds + PG8_SA(b, h) + aoff + m * 2048), hi_ = *(const LAS u32x4*)(lds + PG8_SA(b, h) + aoff + m * 2048 + 1024); \
        dst[m] = (v8i){(int)lo_.x, (int)lo_.y, (int)lo_.z, (int)lo_.w, (int)hi_.x, (int)hi_.y, (int)hi_.z, (int)hi_.w}; } } while (0)
#define PG8_LDB(dst, b, h) do { _Pragma("unroll") for (int n = 0; n < 2; ++n) { const u32x4 lo_ = *(const LAS u32x4*)(lds + PG8_SB(b, h) + boff + n * 2048), hi_ = *(const LAS u32x4*)(lds + PG8_SB(b, h) + boff + n * 2048 + 1024); \
        dst[n] = (v8i){(int)lo_.x, (int)lo_.y, (int)lo_.z, (int)lo_.w, (int)hi_.x, (int)hi_.y, (int)hi_.z, (int)hi_.w}; } } while (0)
#define PG8_MMA(ai, bj, At, Bt) do { __builtin_amdgcn_s_setprio(1); _Pragma("unroll") for (int m = 0; m < 4; ++m) _Pragma("unroll") for (int n = 0; n < 2; ++n) { \
        if constexpr (FP8) acc[ai][bj][m][n] = __builtin_amdgcn_mfma_scale_f32_16x16x128_f8f6f4(Bt[n], At[m], acc[ai][bj][m][n], 0, 0, 0, 0x7f7f7f7f, 0, 0x7f7f7f7f); \
        else { acc[ai][bj][m][n] = __builtin_amdgcn_mfma_f32_16x16x32_bf16(half8(Bt[n], 0), half8(At[m], 0), acc[ai][bj][m][n], 0, 0, 0); \
               acc[ai][bj][m][n] = __builtin_amdgcn_mfma_f32_16x16x32_bf16(half8(Bt[n], 1), half8(At[m], 1), acc[ai][bj][m][n], 0, 0, 0); } } __builtin_amdgcn_s_setprio(0); } while (0)
#define PG8_WAIT_V(n) asm volatile("s_waitcnt vmcnt(" #n ")" ::: "memory")
#define PG8_WAIT_L(n) asm volatile("s_waitcnt lgkmcnt(" #n ")" ::: "memory")
#define PG8_BAR __builtin_amdgcn_s_barrier()
#define PG8_SCHED __builtin_amdgcn_sched_barrier(0)
    Unit cur, nxt; int ui = 0;
    if (!S.next(0, cur)) return;
    f32x4 acc[2][2][4][2];
#pragma unroll
    for (int a = 0; a < 2; ++a)
#pragma unroll
        for (int b = 0; b < 2; ++b)
#pragma unroll
            for (int m = 0; m < 4; ++m)
#pragma unroll
                for (int n = 0; n < 2; ++n) acc[a][b][m][n] = (f32x4){0.f, 0.f, 0.f, 0.f};
    typename FragSel<FP8>::A At[4]; typename FragSel<FP8>::A B0[2], B1[2];
    const char* cA = GATHER ? nullptr : S.a_base(cur); const char* cB = S.b_base(cur);
    const char* gA = S.A;
    unsigned selA[2][2], cur1[2], nxtT[2][2];
    if constexpr (GATHER) { S.tok_off(cur, Rrow, coffA, selA); cur1[0] = selA[1][0]; cur1[1] = selA[1][1]; }
    PG8_STAGE(PG8_SB(0, 0), cB, voffB); PG8_STAGE(PG8_SB(0, 1), cB + hstep, voffB);
    if constexpr (GATHER) { PG8_STAGE_G(PG8_SA(0, 0), selA[0], 0); PG8_STAGE_G(PG8_SA(0, 1), selA[1], 0); }
    else { PG8_STAGE(PG8_SA(0, 0), cA, voffA); PG8_STAGE(PG8_SA(0, 1), cA + hstep, voffA); }
    if (wr == 1) PG8_BAR;
    PG8_WAIT_V(2); PG8_BAR;
    PG8_STAGE(PG8_SB(1, 0), cB + kstep, voffB);
    if constexpr (GATHER) PG8_STAGE_G(PG8_SA(1, 0), selA[0], kstep); else PG8_STAGE(PG8_SA(1, 0), cA + kstep, voffA);
    PG8_STAGE(PG8_SB(1, 1), cB + hstep + kstep, voffB);
    PG8_WAIT_V(6); PG8_BAR;
    for (;;) {
        const bool has_next = S.next(ui + 1, nxt);
        const char* nA = (!GATHER && has_next) ? S.a_base(nxt) : cA; const char* nB = has_next ? S.b_base(nxt) : cB;
        if constexpr (GATHER) { if (has_next) S.tok_off(nxt, Rrow, coffA, nxtT); }
        for (int t = 0; t < nt; t += 2) {
            const bool last = (t == nt - 2);
            const char* a1 = GATHER ? nullptr : cA + (size_t)(t + 1) * kstep;
            const char* a2 = GATHER ? nullptr : (last ? nA : cA + (size_t)(t + 2) * kstep); const char* b2 = last ? nB : cB + (size_t)(t + 2) * kstep;
            const char* a3 = GATHER ? nullptr : a2 + kstep; const char* b3 = b2 + kstep;
            const unsigned k1 = (unsigned)((t + 1) * kstep), k2 = last ? 0u : (unsigned)((t + 2) * kstep), k3 = k2 + (unsigned)kstep;
            PG8_LDB(B0, 0, 0); PG8_LDB(B1, 0, 1); PG8_SCHED; PG8_LDA(At, 0, 0);
            if constexpr (GATHER) PG8_STAGE_G(PG8_SA(1, 1), cur1, k1); else PG8_STAGE(PG8_SA(1, 1), a1 + hstep, voffA);
            if constexpr (GATHER) { if (last && has_next) {
#pragma unroll
                for (int h = 0; h < 2; ++h)
#pragma unroll
                    for (int i = 0; i < 2; ++i) selA[h][i] = nxtT[h][i]; } }
            PG8_WAIT_V(8); PG8_WAIT_L(0); PG8_BAR; PG8_MMA(0, 0, At, B0); PG8_MMA(0, 1, At, B1); PG8_BAR; PG8_SCHED;
            PG8_LDA(At, 0, 1); PG8_STAGE(PG8_SB(0, 0), b2, voffB); PG8_STAGE(PG8_SB(0, 1), b2 + hstep, voffB);
            if constexpr (GATHER) PG8_STAGE_G(PG8_SA(0, 0), selA[0], k2); else PG8_STAGE(PG8_SA(0, 0), a2, voffA);
            PG8_WAIT_V(8); PG8_WAIT_L(0); PG8_BAR; PG8_MMA(1, 0, At, B0); PG8_MMA(1, 1, At, B1); PG8_BAR; PG8_SCHED;
            PG8_LDB(B0, 1, 0); PG8_LDB(B1, 1, 1); PG8_SCHED; PG8_LDA(At, 1, 0);
            if constexpr (GATHER) PG8_STAGE_G(PG8_SA(0, 1), selA[1], k2); else PG8_STAGE(PG8_SA(0, 1), a2 + hstep, voffA);
            PG8_WAIT_V(8); PG8_WAIT_L(0); PG8_BAR; PG8_MMA(0, 0, At, B0); PG8_MMA(0, 1, At, B1); PG8_BAR; PG8_SCHED;
            PG8_LDA(At, 1, 1); PG8_STAGE(PG8_SB(1, 0), b3, voffB); PG8_STAGE(PG8_SB(1, 1), b3 + hstep, voffB);
            if constexpr (GATHER) PG8_STAGE_G(PG8_SA(1, 0), selA[0], k3); else PG8_STAGE(PG8_SA(1, 0), a3, voffA);
            PG8_WAIT_V(8); PG8_WAIT_L(0); PG8_BAR; PG8_MMA(1, 0, At, B0); PG8_MMA(1, 1, At, B1); PG8_BAR; PG8_SCHED;
        }
        if (wr == 0) PG8_BAR;
        { int fr_ = fr, fq_ = fq; asm volatile("" : "+v"(fr_), "+v"(fq_));
          E(acc, cur, wr, wc, fr_, fq_); }
        if (!has_next) break;
#pragma unroll
        for (int a = 0; a < 2; ++a)
#pragma unroll
            for (int b = 0; b < 2; ++b)
#pragma unroll
                for (int m = 0; m < 4; ++m)
#pragma unroll
                    for (int n = 0; n < 2; ++n) acc[a][b][m][n] = (f32x4){0.f, 0.f, 0.f, 0.f};
        cur = nxt; cA = nA; cB = nB; ++ui;
        if constexpr (GATHER) { cur1[0] = selA[1][0]; cur1[1] = selA[1][1]; }
        if (wr == 1) PG8_BAR;
    }
    PG8_WAIT_V(0);
    PG8_BAR;
#undef PG8_SA
#undef PG8_SB
#undef PG8_STAGE
#undef PG8_STAGE_G
#undef PG8_LDA
#undef PG8_LDB
#undef PG8_MMA
#undef PG8_WAIT_V
#undef PG8_WAIT_L
#undef PG8_BAR
#undef PG8_SCHED
}
}

#define XB_TMO      128
#define XB_XCNT(j)  (256  + 64 * (j))
#define XB_XSUB(j)  (1280 + 64 * (j))
#define XB_XGEN(j)  (2304 + 64 * (j))
#define XB_TOP      3328
#define XB_TOPGEN   3392
#define XCD_BAR_WORDS 3456
#define XB_SPIN_CAP (1u << 18)
__device__ __forceinline__ unsigned xb_ld(unsigned* p)              { return __hip_atomic_load(p, __ATOMIC_RELAXED, __HIP_MEMORY_SCOPE_AGENT); }
__device__ __forceinline__ unsigned xb_add(unsigned* p, unsigned v) { return __hip_atomic_fetch_add(p, v, __ATOMIC_RELAXED, __HIP_MEMORY_SCOPE_AGENT); }
__device__ __forceinline__ unsigned xb_xcc_id() { return (unsigned)__builtin_amdgcn_s_getreg((3 << 11) | 20) & 0xFu; }
#define XB_SPIN(cond, bar) do { unsigned _sp = 0; while (cond) { __builtin_amdgcn_s_sleep(1); \
    if ((++_sp & 255u) == 0u) { if (xb_ld(&(bar)[XB_TMO])) break; if (_sp > XB_SPIN_CAP) { atomicAdd(&(bar)[XB_TMO], 1u); break; } } } } while (0)
struct XcdBarrier { unsigned* bar; unsigned x; volatile LAS unsigned* st; };
__device__ __forceinline__ XcdBarrier xcd_barrier_post(unsigned* bar, volatile LAS unsigned* st) {
    XcdBarrier b; b.bar = bar; b.x = xb_xcc_id(); b.st = st;
    if (threadIdx.x == 0) (void)xb_add(&bar[XB_XCNT(b.x)], 1u);
    return b;
}
__device__ __forceinline__ void xcd_barrier_complete(unsigned* bar, unsigned x, unsigned& nloc, unsigned& nx) {
    const unsigned G = gridDim.x * gridDim.y * gridDim.z;
    unsigned sum, cnt, mine, sp = 0u;
    for (;;) {
        sum = 0u; cnt = 0u; mine = 0u;
#pragma unroll
        for (unsigned j = 0; j < 16; ++j) { const unsigned c = xb_ld(&bar[XB_XCNT(j)]); sum += c; cnt += (c > 0u) ? 1u : 0u; mine = (j == x) ? c : mine; }
        if (sum == G) break;
        __builtin_amdgcn_s_sleep(1);
        if ((++sp & 255u) == 0u) { if (xb_ld(&bar[XB_TMO])) break; if (sp > XB_SPIN_CAP) { atomicAdd(&bar[XB_TMO], 1u); break; } }
    }
    nloc = mine > 0u ? mine : 1u; nx = cnt > 0u ? cnt : 1u;
}
__device__ __forceinline__ void xcd_barrier(const XcdBarrier& b) {
    asm volatile("s_waitcnt vmcnt(0)" ::: "memory");
    __syncthreads();
    if (threadIdx.x == 0) {
        unsigned* bar = b.bar;
        __builtin_amdgcn_s_waitcnt(0);
        unsigned nloc = b.st[0], nx = b.st[1];
        if (nloc == 0u) { xcd_barrier_complete(bar, b.x, nloc, nx); b.st[0] = nloc; b.st[1] = nx; }
        const unsigned old = xb_add(&bar[XB_XSUB(b.x)], 1u);
        const unsigned gen = old / nloc;
        if (old + 1u == (gen + 1u) * nloc) {
            __builtin_amdgcn_fence(__ATOMIC_RELEASE, "agent");
            asm volatile("s_waitcnt vmcnt(0)" ::: "memory");
            const unsigned og = xb_add(&bar[XB_TOP], 1u);
            const unsigned tg = og / nx;
            if (og + 1u == (tg + 1u) * nx) xb_add(&bar[XB_TOPGEN], 1u);
            else XB_SPIN(xb_ld(&bar[XB_TOPGEN]) == tg, bar);
            __builtin_amdgcn_fence(__ATOMIC_ACQUIRE, "agent");
            xb_add(&bar[XB_XGEN(b.x)], 1u);
            asm volatile("s_waitcnt vmcnt(0)" ::: "memory");
        } else {
            XB_SPIN(xb_ld(&bar[XB_XGEN(b.x)]) == gen, bar);
            __builtin_amdgcn_fence(__ATOMIC_ACQUIRE, "agent");
            asm volatile("s_waitcnt vmcnt(0)" ::: "memory");
        }
    }
    __syncthreads();
}

constexpr size_t MiB = 1u << 20;
constexpr size_t WS_CTL = 0, CTL_ZERO_BYTES = 128 * 1024;
constexpr int CW_BAR = 4096, CW_CNT = 16384;
constexpr size_t WS_MOD   = 1 * MiB;
constexpr size_t WS_ROPE  = 2 * MiB;
constexpr size_t WS_XC    = 3 * MiB;
constexpr size_t WS_XB    = 1700 * MiB;
constexpr size_t WS_WCIN  = 11 * MiB;
constexpr size_t WS_WCOUT = 23 * MiB;
constexpr size_t WS_WMLN  = 27 * MiB;
constexpr size_t WS_WMLS  = 31 * MiB;
constexpr size_t WS_WMLO  = 34 * MiB;
constexpr size_t WS_WMLG  = 36 * MiB;
constexpr size_t WS_WDN   = 37 * MiB;
constexpr size_t WS_WUQ   = 39 * MiB;
constexpr size_t WS_WKN   = 41 * MiB;
constexpr size_t WS_WV    = 42 * MiB;
constexpr size_t WS_WMO   = 43 * MiB;
constexpr size_t WS_WR    = 45 * MiB;
constexpr size_t WS_TOPE  = 46 * MiB;
constexpr size_t WS_TPOS  = 47 * MiB;
constexpr size_t WS_GATE  = 48 * MiB;
constexpr size_t WS_LIST  = 49 * MiB;
constexpr size_t WS_G32   = 54 * MiB;
constexpr size_t WS_SCU   = 59 * MiB;
constexpr size_t WS_SCMU  = 62 * MiB;
static_assert(true, "");
constexpr size_t WS_SCB   = 65 * MiB;
constexpr size_t WS_CHM   = 68 * MiB;
constexpr size_t WS_NST   = 69 * MiB;
constexpr size_t WS_W1    = 72 * MiB;
constexpr size_t WS_W2    = 584 * MiB;
constexpr size_t WS_H     = 840 * MiB;
constexpr size_t WS_A0    = 908 * MiB;
constexpr size_t WS_A1    = 1012 * MiB;
constexpr size_t WS_A2    = 1116 * MiB;
constexpr size_t WS_A3    = 1220 * MiB;
constexpr size_t WS_A4    = 1292 * MiB;
constexpr size_t WS_A5    = 1364 * MiB;
constexpr size_t WS_A6    = 1504 * MiB;
constexpr size_t WS_XP    = 1624 * MiB;
constexpr size_t WS_ACT   = 1912 * MiB;
constexpr size_t WS_Y     = 2200 * MiB;
constexpr size_t WS_END   = 2488 * MiB;

constexpr int RING_BYTES = 131072, MISC_OFF = RING_BYTES, LDS_BYTES = 147456;
constexpr int MI_PEXP = 1152;
constexpr int MI_BAR = 0, MI_PPRE = 16, MI_HIST = 64, MI_BASE = 96, MI_SCR = 128, MI_CNT = 960, MI_INP = 1024;

struct Args { const float* in[31]; float* out; unsigned char* ws; int ph_lo, ph_hi; };

struct Frame {
    LAS unsigned char* lds; volatile LAS int* MISC; unsigned* ctl; unsigned char* ws;
    int tid, lane, wave, G, vcu;
    float* out;
};
__device__ __forceinline__ const float* inp(const Frame& F, int i) {
    const unsigned lo = __builtin_amdgcn_readfirstlane((unsigned)F.MISC[MI_INP + 2 * i]), hi = __builtin_amdgcn_readfirstlane((unsigned)F.MISC[MI_INP + 2 * i + 1]);
    return (const float*)(__attribute__((address_space(1))) const float*)(((unsigned long long)hi << 32) | lo);
}
#define IN_X 0
#define IN_C 1
#define IN_CTX 2
#define IN_CCTX 3
#define IN_NORM_MIX 4
#define IN_NORM_FFN 5
#define IN_W_MOD 6
#define IN_B_MOD 7
#define IN_CONV_W_IN 8
#define IN_CONV_W 9
#define IN_CONV_W_OUT 10
#define IN_ML_W_IN 11
#define IN_ML_B_GATE 12
#define IN_ML_NORM 13
#define IN_ML_W_OUT 14
#define IN_MLA_W_IN 15
#define IN_MLA_Q_NORM 16
#define IN_MLA_KV_NORM 17
#define IN_MLA_W_UQ 18
#define IN_MLA_W_UKV 19
#define IN_MLA_QN_NOPE 20
#define IN_MLA_QN_ROPE 21
#define IN_MLA_KN_NOPE 22
#define IN_MLA_KN_ROPE 23
#define IN_MLA_W_OUT 24
#define IN_MOE_W_ROUTER 25
#define IN_MOE_B_ROUTER 26
#define IN_MOE_W1 27
#define IN_MOE_B1 28
#define IN_MOE_W2 29
#define IN_MOE_B2 30

#define WSP(T, off) ((T*)(F.ws + (off)))

constexpr int TR_STR = 136, TR_BYTES = 64 * TR_STR;
__device__ __forceinline__ void transpose_item(const float* W, int ldn, int k0, int n0, int nvalid, bf16_t* WT, int Kd, int drow0, LAS unsigned char* scr, int lane) {
    const float* wp = W + (size_t)k0 * ldn + n0 + (lane < nvalid ? lane : 0);
    float v[64];
#pragma unroll
    for (int kk = 0; kk < 64; ++kk) v[kk] = __builtin_nontemporal_load(wp + (size_t)kk * ldn);
#pragma unroll
    for (int kp = 0; kp < 32; ++kp) *(LAS unsigned*)(scr + lane * TR_STR + kp * 4) = cvt_pk_bf16(v[2 * kp], v[2 * kp + 1]);
    asm volatile("s_waitcnt lgkmcnt(0)" ::: "memory");
#pragma unroll
    for (int j = 0; j < 8; ++j) { const int q = lane + 64 * j, n = q >> 3, c = q & 7; const LAS unsigned char* p = scr + n * TR_STR + c * 16;
        const u32x2 lo = *(const LAS u32x2*)p, hi = *(const LAS u32x2*)(p + 8);
        if (n < nvalid) *(u32x4*)(WT + (size_t)(drow0 + n) * Kd + k0 + 8 * c) = (u32x4){lo.x, lo.y, hi.x, hi.y}; }
    asm volatile("s_waitcnt lgkmcnt(0)" ::: "memory");
}
constexpr int TR8_STR = 136;
__device__ __forceinline__ void transpose_item_f8(const float* W, int ldn, int k0, int n0, unsigned char* WT, int Kd, int drow0, LAS unsigned char* scr, int lane) {
#pragma unroll
    for (int half = 0; half < 2; ++half) {
        const float* wp = W + (size_t)(k0 + 64 * half) * ldn + n0 + lane;
        float v[64];
#pragma unroll
        for (int kk = 0; kk < 64; ++kk) v[kk] = __builtin_nontemporal_load(wp + (size_t)kk * ldn);
#pragma unroll
        for (int kq = 0; kq < 16; ++kq) *(LAS unsigned*)(scr + lane * TR8_STR + half * 64 + kq * 4) = pk_fp8x4(v[4 * kq] * W8_SCALE, v[4 * kq + 1] * W8_SCALE, v[4 * kq + 2] * W8_SCALE, v[4 * kq + 3] * W8_SCALE);
    }
    asm volatile("s_waitcnt lgkmcnt(0)" ::: "memory");
#pragma unroll
    for (int j = 0; j < 8; ++j) { const int q = lane + 64 * j, n = q >> 3, c = q & 7; const LAS unsigned char* p = scr + n * TR8_STR + c * 16;
        const u32x2 lo = *(const LAS u32x2*)p, hi = *(const LAS u32x2*)(p + 8);
        __builtin_nontemporal_store((u32x4){lo.x, lo.y, hi.x, hi.y}, (u32x4*)(WT + (size_t)(drow0 + n) * Kd + k0 + 16 * c)); }
    asm volatile("s_waitcnt lgkmcnt(0)" ::: "memory");
}
__device__ __forceinline__ int map_pair128(int n0, int half) { return (n0 >> 7) * 256 + half * 128 + (n0 & 127); }

__device__ __forceinline__ void phase_prologue(Frame& F) {
    LAS unsigned char* scr = F.lds + F.wave * TR_BYTES;
    const int gw = F.vcu * 8 + F.wave, NGW = F.G * 8;
    constexpr int I_CIN = 16 * 48, I_COUT = 8 * 16, I_MLIN = 8 * 48 + 16, I_MLK2 = 8 * 8, I_MLO = 8 * 16, I_DN = 16 * 11, I_UQ = 6 * 24, I_UKV = 4 * 32, I_MO = 8 * 16, I_R = 16 * 1, I_W1 = 8 * 32, I_W2 = 8 * 16;
    constexpr int N_SMALL = 2 * I_CIN + 2 * I_COUT + I_MLIN + I_MLK2 + I_MLO + I_DN + I_UQ + I_UKV + I_MO + 4 * I_R;
    constexpr int N_W1 = 128 * I_W1, N_W2 = 128 * I_W2;
    constexpr int NITEMS = N_SMALL + N_W1 + N_W2;
    for (int it = gw; it < NITEMS; it += NGW) {
        int r = NITEMS - 1 - it;
        if (r >= N_SMALL) {
            r -= N_SMALL;
            if (r < N_W1) { const int mat = r / I_W1, q = r % I_W1, kb = q / 32, nb = q % 32, n0 = nb * 64;
                const int drow = n0 < 1024 ? map_pair128(n0, 0) : map_pair128(n0 - 1024, 1);
                transpose_item_f8(inp(F, IN_MOE_W1) + (size_t)mat * 1024 * 2048, 2048, kb * 128, n0, WSP(unsigned char, WS_W1) + (size_t)mat * 2048 * 1024, 1024, drow, scr, F.lane); continue; }
            r -= N_W1;
            { const int mat = r / I_W2, q = r % I_W2, kb = q / 16, nb = q % 16;
                transpose_item_f8(inp(F, IN_MOE_W2) + (size_t)mat * 1024 * 1024, 1024, kb * 128, nb * 64, WSP(unsigned char, WS_W2) + (size_t)mat * 1024 * 1024, 1024, nb * 64, scr, F.lane); continue; }
        }
        if (r < 2 * I_CIN) { const int mat = r / I_CIN, q = r % I_CIN, kb = q / 48, nb = q % 48, n0 = nb * 64;
            const int drow = n0 < 1024 ? n0 : (n0 < 2048 ? 1024 + map_pair128(n0 - 1024, 0) : 1024 + map_pair128(n0 - 2048, 1));
            transpose_item(inp(F, IN_CONV_W_IN) + (size_t)mat * 1024 * 3072, 3072, kb * 64, n0, 64, WSP(bf16_t, WS_WCIN) + (size_t)mat * 3072 * 1024, 1024, drow, scr, F.lane); continue; }
        r -= 2 * I_CIN;
        if (r < 2 * I_COUT) { const int mat = r / I_COUT, q = r % I_COUT, kb = q / 16, nb = q % 16;
            transpose_item_f8(inp(F, IN_CONV_W_OUT) + (size_t)mat * 1024 * 1024, 1024, kb * 128, nb * 64, WSP(unsigned char, WS_WCOUT) + (size_t)mat * 1024 * 1024, 1024, nb * 64, scr, F.lane); continue; }
        r -= 2 * I_COUT;
        if (r < I_MLIN) {
            if (r < 8 * 48) { const int kb = r / 48, nb = r % 48, n0 = nb * 64;
                unsigned char* dst; int drow;
                if (n0 < 1024) { dst = WSP(unsigned char, WS_WMLN); drow = n0; }
                else if (n0 < 2048) { dst = WSP(unsigned char, WS_WMLS); drow = 512 + (n0 - 1024); }
                else { dst = WSP(unsigned char, WS_WMLN); drow = 1024 + (n0 - 2048); }
                transpose_item_f8(inp(F, IN_ML_W_IN), 3104, kb * 128, n0, dst, 1024, drow, scr, F.lane); }
            else transpose_item(inp(F, IN_ML_W_IN), 3104, (r - 8 * 48) * 64, 3072, 32, WSP(bf16_t, WS_WMLG), 1024, 0, scr, F.lane);
            continue; }
        r -= I_MLIN;
        if (r < I_MLK2) { const int kb = r / 8, nb = r % 8, n0 = 512 + nb * 64;
            transpose_item_f8(inp(F, IN_ML_W_IN), 3104, kb * 128, n0, WSP(unsigned char, WS_WMLS), 1024, n0 - 512, scr, F.lane); continue; }
        r -= I_MLK2;
        if (r < I_MLO) { const int kb = r / 16, nb = r % 16;
            transpose_item_f8(inp(F, IN_ML_W_OUT), 1024, kb * 128, nb * 64, WSP(unsigned char, WS_WMLO), 1024, nb * 64, scr, F.lane); continue; }
        r -= I_MLO;
        if (r < I_DN) { const int kb = r / 11, nb = r % 11;
            transpose_item(inp(F, IN_MLA_W_IN), 704, kb * 64, nb * 64, 64, WSP(bf16_t, WS_WDN), 1024, nb * 64, scr, F.lane); continue; }
        r -= I_DN;
        if (r < I_UQ) { const int kb = r / 24, nb = r % 24;
            transpose_item(inp(F, IN_MLA_W_UQ), 1536, kb * 64, nb * 64, 64, WSP(bf16_t, WS_WUQ), 384, nb * 64, scr, F.lane); continue; }
        r -= I_UQ;
        if (r < I_UKV) { const int kb = r / 32, nb = r % 32, n0 = nb * 64, hd = n0 >> 8, within = n0 & 255;
            bf16_t* dst = within < 128 ? WSP(bf16_t, WS_WKN) : WSP(bf16_t, WS_WV);
            transpose_item(inp(F, IN_MLA_W_UKV), 2048, kb * 64, n0, 64, dst, 256, hd * 128 + (within & 127), scr, F.lane); continue; }
        r -= I_UKV;
        if (r < I_MO) { const int kb = r / 16, nb = r % 16;
            transpose_item_f8(inp(F, IN_MLA_W_OUT), 1024, kb * 128, nb * 64, WSP(unsigned char, WS_WMO), 1024, nb * 64, scr, F.lane); continue; }
        r -= I_MO;
        { const int mat = r / I_R, kb = r % I_R;
            transpose_item(inp(F, IN_MOE_W_ROUTER) + (size_t)mat * 1024 * 32, 32, kb * 64, 0, 32, WSP(bf16_t, WS_WR) + (size_t)mat * 32 * 1024, 1024, 0, scr, F.lane); }
    }
    { u32x4* z = (u32x4*)(WSP(bf16_t, WS_WDN) + (size_t)704 * 1024); const int n16 = 64 * 1024 * 2 / 16;
      for (int i = blockIdx.x * 512 + F.tid; i < n16; i += F.G * 512) z[i] = (u32x4){0u, 0u, 0u, 0u}; }
    if (blockIdx.x == 0) {
        float* rc = WSP(float, WS_ROPE); float* rs = rc + 1024;
        for (int i = F.tid; i < 1024; i += 512) { const int pos = i >> 4, f = i & 15;
            const float inv = exp2f(-(float)f * (13.287712379549449f / 16.0f));
            const float ang = (float)pos * inv; rc[i] = cosf(ang); rs[i] = sinf(ang); }
    }
    __syncthreads();
    {
        LAS float* sl = (LAS float*)(F.lds);
        LAS float* red = (LAS float*)(F.lds + 36864);
        for (int idx = F.tid; idx < 9 * 1024; idx += 512) { const int rr = idx >> 10, k = idx & 1023; const float cv = rr < 8 ? inp(F, IN_C)[rr * 1024 + k] : inp(F, IN_CCTX)[k]; sl[idx] = cv * sigmoidf_(cv); }
        __syncthreads();
        float* MOD = WSP(float, WS_MOD);
        for (int unit = blockIdx.x; unit < 4 * 96; unit += F.G) {
            const int l = unit / 96, n0 = (unit % 96) * 64, n = n0 + F.lane;
            float acc[9];
#pragma unroll
            for (int q = 0; q < 9; ++q) acc[q] = 0.f;
            const float* wp = inp(F, IN_W_MOD) + ((size_t)l * 1024 + F.wave * 128) * 6144 + n;
#pragma unroll 16
            for (int kk = 0; kk < 128; ++kk) { const float wv = wp[(size_t)kk * 6144]; const int k = F.wave * 128 + kk;
#pragma unroll
                for (int q = 0; q < 9; ++q) acc[q] += sl[q * 1024 + k] * wv; }
#pragma unroll
            for (int q = 0; q < 9; ++q) red[(F.wave * 9 + q) * 64 + F.lane] = acc[q];
            __syncthreads();
            for (int idx = F.tid; idx < 576; idx += 512) { const int q = idx >> 6, ln = idx & 63; float s = 0.f;
#pragma unroll
                for (int w = 0; w < 8; ++w) s += red[(w * 9 + q) * 64 + ln];
                MOD[((size_t)l * 9 + q) * 6144 + n0 + ln] = s + inp(F, IN_B_MOD)[l * 6144 + n0 + ln]; }
            __syncthreads();
        }
    }
}

__device__ __forceinline__ void moe_tables(Frame& F, int layer, bool panel_table = false) {
    if (F.wave == 0) {
        const int lane = F.lane; const unsigned* cnt = F.ctl + CW_CNT + layer * 64;
        const int c = (int)cnt[lane & (NEXP - 1)], np = lane < NEXP ? (c + 255) >> 8 : 0;
        int incl = np;
#pragma unroll
        for (int o = 1; o < NEXP; o <<= 1) { const int t = __builtin_amdgcn_ds_bpermute((lane - o) << 2, incl); if (lane >= o) incl += t; }
        if (lane < NEXP) { F.MISC[MI_PPRE + lane] = incl - np; F.MISC[MI_CNT + lane] = c; }
        if (lane == NEXP - 1) F.MISC[MI_PPRE + NEXP] = incl;
    }
    __syncthreads();
    if (panel_table) {
        const int np = F.MISC[MI_PPRE + NEXP];
        for (int p = F.tid; p < np; p += 512) { int e = 0;
#pragma unroll 8
            for (int k = 1; k < NEXP; ++k) e += (F.MISC[MI_PPRE + k] <= p) ? 1 : 0;
            F.MISC[MI_PEXP + p] = e; }
        __syncthreads();
    }
}

__device__ __forceinline__ float wave_sum_fast(float v, int lane) {
    v += __int_as_float(__builtin_amdgcn_update_dpp(0, __float_as_int(v), 0xB1, 0xF, 0xF, true));
    v += __int_as_float(__builtin_amdgcn_update_dpp(0, __float_as_int(v), 0x4E, 0xF, 0xF, true));
    v += __int_as_float(__builtin_amdgcn_update_dpp(0, __float_as_int(v), 0x141, 0xF, 0xF, true));
    v += __int_as_float(__builtin_amdgcn_update_dpp(0, __float_as_int(v), 0x140, 0xF, 0xF, true));
    v = xsum16(v); v = xsum32(v);
    return v;
}
#define PN_COL(jj) (8 * lane + 512 * ((jj) >> 1) + 4 * ((jj) & 1))
__device__ __forceinline__ void moe_y_load(const Frame& F, const unsigned char* Y, const int (&e4)[4], const int (&p4)[4], int lane, unsigned (&yv)[4][4]) {
#pragma unroll
    for (int k = 0; k < 4; ++k) { const unsigned char* yr = Y + ((size_t)F.MISC[MI_PPRE + e4[k]] * 256 + p4[k]) * D + 8 * lane;
#pragma unroll
        for (int j2 = 0; j2 < 2; ++j2) { const u32x2 t = *(const u32x2*)(yr + 512 * j2); yv[k][2 * j2] = t.x; yv[k][2 * j2 + 1] = t.y; } }
}
__device__ __forceinline__ void moe_y_sum(const unsigned (&yv)[4][4], const float (&g4)[4], f32x4 (&ys)[4]) {
#pragma unroll
    for (int j = 0; j < 4; ++j) { ys[j] = (f32x4){0.f, 0.f, 0.f, 0.f};
#pragma unroll
        for (int k = 0; k < 4; ++k) { const f32x2 lo = __builtin_amdgcn_cvt_pk_f32_fp8((int)yv[k][j], false), hi = __builtin_amdgcn_cvt_pk_f32_fp8((int)yv[k][j], true);
            ys[j][0] += g4[k] * lo.x; ys[j][1] += g4[k] * lo.y; ys[j][2] += g4[k] * hi.x; ys[j][3] += g4[k] * hi.y; } }
}
template <bool FIRST, bool COMBINE, int EXTRA>
__device__ __forceinline__ void phase_norm(Frame& F, int layer, int which, int row_lo, int row_hi) {
    const int lane = F.lane;
    const float* MOD = WSP(float, WS_MOD);
    bf16_t* XB = WSP(bf16_t, WS_XB);
    bf16_t* H = WSP(bf16_t, WS_H); unsigned char* H8 = WSP(unsigned char, WS_XP);
    int* TOPE = WSP(int, WS_TOPE); int* TPOS = WSP(int, WS_TPOS); float* GATE = WSP(float, WS_GATE);
    const unsigned char* Y = WSP(unsigned char, WS_Y);
    if (COMBINE) moe_tables(F, layer - 1);
    if (EXTRA != 0) {
        const bf16_t* W32g = (EXTRA == 1) ? WSP(bf16_t, WS_WR) + (size_t)layer * 32 * 1024 : WSP(bf16_t, WS_WMLG);
        u32x4 wv[8];
#pragma unroll
        for (int i = 0; i < 8; ++i) { const int pc = F.tid + 512 * i; wv[i] = *(const u32x4*)(W32g + (size_t)(pc >> 7) * 1024 + (pc & 127) * 8); }
#pragma unroll
        for (int i = 0; i < 8; ++i) { const int pc = F.tid + 512 * i; *(LAS u32x4*)(F.lds + (pc >> 7) * 2064 + (pc & 127) * 16) = wv[i]; }
        if (EXTRA == 1) { if (F.tid < 32) F.MISC[MI_HIST + F.tid] = 0; }
        __syncthreads();
    }
    const float* gain = inp(F, which ? IN_NORM_FFN : IN_NORM_MIX) + layer * 1024;
    const int gw = blockIdx.x * 8 + F.wave, NGW = F.G * 8;
    const int nrows = row_hi - row_lo, rpw = (nrows + NGW - 1) / NGW;
    const int r0 = row_lo + gw * rpw, r1 = (r0 + rpw < row_hi) ? r0 + rpw : row_hi;
    const int fr = lane & 15, fq = lane >> 4;
    constexpr int NR = COMBINE ? 2 : 4;
    f32x4 cA[4], cB[4], cG[4]; int cb = -1, cgb = -1;
#pragma unroll
    for (int j = 0; j < 4; ++j) { cA[j] = (f32x4){0.f, 0.f, 0.f, 0.f}; cB[j] = cA[j]; cG[j] = cA[j]; }
    for (int rg = r0; rg < r1; rg += NR) {
        f32x4 v[NR][4]; int b9[NR]; bool act[NR];
#pragma unroll
        for (int q = 0; q < NR; ++q) {
            act[q] = rg + q < r1; const int row = act[q] ? rg + q : rg; const bool isctx = row < T_CTX;
            b9[q] = isctx ? 8 : ((row - T_CTX) >> 12);
            if (FIRST) { const float* xs = isctx ? inp(F, IN_CTX) + (size_t)row * D : inp(F, IN_X) + (size_t)(row - T_CTX) * D;
#pragma unroll
                for (int j = 0; j < 4; ++j) v[q][j] = *(const f32x4*)(xs + PN_COL(j));
            } else { const bf16_t* xs = XB + (size_t)row * D;
#pragma unroll
                for (int j2 = 0; j2 < 2; ++j2) { const u32x4 t = *(const u32x4*)(xs + 8 * lane + 512 * j2); v[q][2 * j2] = (f32x4){bflo(t.x), bfhi(t.x), bflo(t.y), bfhi(t.y)}; v[q][2 * j2 + 1] = (f32x4){bflo(t.z), bfhi(t.z), bflo(t.w), bfhi(t.w)}; } }
        }
        if (COMBINE) {
            unsigned yv[NR][4][4]; float g4[NR][4];
#pragma unroll
            for (int q = 0; q < NR; ++q) { const int row = act[q] ? rg + q : rg; int e4[4], p4[4];
                const int4 ev = *(const int4*)(TOPE + row * 4), pv = *(const int4*)(TPOS + row * 4); const f32x4 gv = *(const f32x4*)(GATE + row * 4);
                e4[0] = __builtin_amdgcn_readfirstlane(ev.x); e4[1] = __builtin_amdgcn_readfirstlane(ev.y); e4[2] = __builtin_amdgcn_readfirstlane(ev.z); e4[3] = __builtin_amdgcn_readfirstlane(ev.w);
                p4[0] = __builtin_amdgcn_readfirstlane(pv.x); p4[1] = __builtin_amdgcn_readfirstlane(pv.y); p4[2] = __builtin_amdgcn_readfirstlane(pv.z); p4[3] = __builtin_amdgcn_readfirstlane(pv.w);
                g4[q][0] = gv[0]; g4[q][1] = gv[1]; g4[q][2] = gv[2]; g4[q][3] = gv[3];
                moe_y_load(F, Y, e4, p4, lane, yv[q]); }
#pragma unroll
            for (int q = 0; q < NR; ++q) { const int row = act[q] ? rg + q : rg; const bool isctx = row < T_CTX;
                f32x4 ys[4]; moe_y_sum(yv[q], g4[q], ys);
                if (b9[q] != cgb) { cgb = b9[q]; const float* gf = MOD + ((size_t)(layer - 1) * 9 + cgb) * 6144 + 5 * 1024;
#pragma unroll
                    for (int j = 0; j < 4; ++j) cG[j] = *(const f32x4*)(gf + PN_COL(j)); }
                bf16_t* xd = XB + (size_t)row * D;
#pragma unroll
                for (int j = 0; j < 4; ++j) v[q][j] = v[q][j] + cG[j] * ys[j];
#pragma unroll
                for (int j2 = 0; j2 < 2; ++j2) if (act[q]) { u32x4 o; o.x = cvt_pk_bf16(v[q][2 * j2][0], v[q][2 * j2][1]); o.y = cvt_pk_bf16(v[q][2 * j2][2], v[q][2 * j2][3]);
                    o.z = cvt_pk_bf16(v[q][2 * j2 + 1][0], v[q][2 * j2 + 1][1]); o.w = cvt_pk_bf16(v[q][2 * j2 + 1][2], v[q][2 * j2 + 1][3]); *(u32x4*)(xd + 8 * lane + 512 * j2) = o; } }
        }
#pragma unroll
        for (int q = 0; q < NR; ++q) {
            const int row = act[q] ? rg + q : rg;
            float ss = 0.f;
#pragma unroll
            for (int j = 0; j < 4; ++j) ss += (v[q][j][0] * v[q][j][0] + v[q][j][1] * v[q][j][1]) + (v[q][j][2] * v[q][j][2] + v[q][j][3] * v[q][j][3]);
            const float rstd = 1.0f / sqrtf(wave_sum_fast(ss, lane) * (1.0f / D) + RMS_EPS);
            if (b9[q] != cb) { cb = b9[q]; const float* mp = MOD + ((size_t)layer * 9 + cb) * 6144;
#pragma unroll
                for (int j = 0; j < 4; ++j) { const f32x4 g4v = *(const f32x4*)(gain + PN_COL(j));
                    const f32x4 sc = *(const f32x4*)(mp + (which ? 4 : 1) * 1024 + PN_COL(j)); cB[j] = *(const f32x4*)(mp + (which ? 3 : 0) * 1024 + PN_COL(j)); cA[j] = g4v * (sc + 1.0f); } }
#pragma unroll
            for (int j2 = 0; j2 < 2; ++j2) {
                const f32x4 h0 = (v[q][2 * j2] * rstd) * cA[2 * j2] + cB[2 * j2], h1 = (v[q][2 * j2 + 1] * rstd) * cA[2 * j2 + 1] + cB[2 * j2 + 1];
                u32x4 o; o.x = cvt_pk_bf16(h0[0], h0[1]); o.y = cvt_pk_bf16(h0[2], h0[3]); o.z = cvt_pk_bf16(h1[0], h1[1]); o.w = cvt_pk_bf16(h1[2], h1[3]);
                if (act[q]) *(u32x4*)(H + (size_t)row * D + 8 * lane + 512 * j2) = o;
                if (EXTRA != 0) { if (act[q]) { u32x2 o8;
                    o8.x = pk_fp8x4(__builtin_amdgcn_fmed3f(h0[0], -448.f, 448.f), __builtin_amdgcn_fmed3f(h0[1], -448.f, 448.f), __builtin_amdgcn_fmed3f(h0[2], -448.f, 448.f), __builtin_amdgcn_fmed3f(h0[3], -448.f, 448.f));
                    o8.y = pk_fp8x4(__builtin_amdgcn_fmed3f(h1[0], -448.f, 448.f), __builtin_amdgcn_fmed3f(h1[1], -448.f, 448.f), __builtin_amdgcn_fmed3f(h1[2], -448.f, 448.f), __builtin_amdgcn_fmed3f(h1[3], -448.f, 448.f));
                    *(u32x2*)(H8 + (size_t)row * D + 8 * lane + 512 * j2) = o8; } }
            }
        }
    }
    if (EXTRA != 0) {
        asm volatile("s_waitcnt vmcnt(0)" ::: "memory");
        for (int t0 = r0; t0 < r1; t0 += 16) {
            const int nval = (r1 - t0 < 16) ? r1 - t0 : 16;
            const int brow = t0 + (fr < nval ? fr : nval - 1);
            f32x4 a0 = (f32x4){0.f, 0.f, 0.f, 0.f}, a1 = a0;
            const bf16_t* hp = H + (size_t)brow * D + 8 * fq;
            const LAS unsigned char* w0p = F.lds + fr * 2064 + 16 * fq; const LAS unsigned char* w1p = w0p + 16 * 2064;
#pragma unroll 4
            for (int ks = 0; ks < 32; ++ks) {
                const bf16x8 hb = *(const bf16x8*)(hp + 32 * ks), w0 = *(const LAS bf16x8*)(w0p + 64 * ks), w1 = *(const LAS bf16x8*)(w1p + 64 * ks);
                a0 = MFMA16(w0, hb, a0); a1 = MFMA16(w1, hb, a1);
            }
            const int row = t0 + fr; const bool rv = fr < nval;
            if (EXTRA == 1) {
                const float* br = inp(F, IN_MOE_B_ROUTER) + layer * 32;
                float vals[8]; int idxs[8];
#pragma unroll
                for (int i = 0; i < 4; ++i) { idxs[i] = 4 * fq + i; vals[i] = a0[i] + br[4 * fq + i]; idxs[4 + i] = 16 + 4 * fq + i; vals[4 + i] = a1[i] + br[16 + 4 * fq + i]; }
                float tv[4]; int ti[4];
#pragma unroll
                for (int k = 0; k < 4; ++k) {
                    float bv = vals[0]; int bi = idxs[0];
#pragma unroll
                    for (int i = 1; i < 8; ++i) { const bool better = vals[i] > bv; bv = better ? vals[i] : bv; bi = better ? idxs[i] : bi; }
xbest16(bv, bi); xbest32(bv, bi);
                    tv[k] = bv; ti[k] = bi;
#pragma unroll
                    for (int i = 0; i < 8; ++i) vals[i] = (idxs[i] == bi) ? -3.0e38f : vals[i];
                }
                const float e1 = fast_exp(tv[1] - tv[0]), e2 = fast_exp(tv[2] - tv[0]), e3 = fast_exp(tv[3] - tv[0]);
                const float inv = 1.0f / (1.0f + e1 + e2 + e3);
                if (fq == 0 && rv) {
                    int rk[4];
#pragma unroll
                    for (int k = 0; k < 4; ++k) rk[k] = __hip_atomic_fetch_add((LAS int*)&F.MISC[MI_HIST + ti[k]], 1, __ATOMIC_RELAXED, __HIP_MEMORY_SCOPE_WORKGROUP);
                    *(int4*)(TOPE + row * 4) = make_int4(ti[0], ti[1], ti[2], ti[3]); *(int4*)(TPOS + row * 4) = make_int4(rk[0], rk[1], rk[2], rk[3]);
                    *(f32x4*)(GATE + row * 4) = (f32x4){inv, e1 * inv, e2 * inv, e3 * inv};
                }
            } else {
                const float* bg = inp(F, IN_ML_B_GATE);
                float* G32 = WSP(float, WS_G32);
                f32x4 o0, o1; const bool isf = (fq >> 1) == 1;
#pragma unroll
                for (int i = 0; i < 4; ++i) {
                    float g = a0[i] + bg[4 * fq + i]; { const float ex = fast_exp(g * (2.0f / 15.0f)); g = 15.0f * (1.0f - 2.0f * fast_rcp(ex + 1.0f)); }
                    if (isf) g = fminf(g, 0.f) - __logf(1.0f + fast_exp(-fabsf(g)));
                    o0[i] = g;
                    float g2 = a1[i] + bg[16 + 4 * fq + i]; { const float ex = fast_exp(g2 * (2.0f / 15.0f)); g2 = 15.0f * (1.0f - 2.0f * fast_rcp(ex + 1.0f)); }
                    if (isf) g2 = fminf(g2, 0.f) - __logf(1.0f + fast_exp(-fabsf(g2)));
                    o1[i] = g2;
                }
                if (rv) { *(f32x4*)(G32 + (size_t)row * 32 + 4 * fq) = o0; *(f32x4*)(G32 + (size_t)row * 32 + 16 + 4 * fq) = o1; }
            }
        }
    }
    if (EXTRA == 1) {
        unsigned* cnt = F.ctl + CW_CNT + layer * 64; int* LIST = WSP(int, WS_LIST);
        __syncthreads();
        if (F.tid < 32) F.MISC[MI_BASE + F.tid] = (int)__hip_atomic_fetch_add(cnt + F.tid, (unsigned)F.MISC[MI_HIST + F.tid], __ATOMIC_RELAXED, __HIP_MEMORY_SCOPE_AGENT);
        __syncthreads();
        for (int t0 = r0; t0 < r1; t0 += 16) {
            const int row = t0 + fr;
            if (fq == 0 && row < r1) {
                const int4 ev = *(const int4*)(TOPE + row * 4); int4 pv = *(const int4*)(TPOS + row * 4);
                pv.x += F.MISC[MI_BASE + ev.x]; pv.y += F.MISC[MI_BASE + ev.y]; pv.z += F.MISC[MI_BASE + ev.z]; pv.w += F.MISC[MI_BASE + ev.w];
                *(int4*)(TPOS + row * 4) = pv;
                LIST[(size_t)ev.x * T_ALL + pv.x] = row; LIST[(size_t)ev.y * T_ALL + pv.y] = row; LIST[(size_t)ev.z * T_ALL + pv.z] = row; LIST[(size_t)ev.w * T_ALL + pv.w] = row;
            }
        }
    }
}

__device__ __forceinline__ void phase_final(Frame& F, int layer) {
    const int lane = F.lane; const float* MOD = WSP(float, WS_MOD); float* XL = F.out; const bf16_t* XB = WSP(bf16_t, WS_XB);
    const int* TOPE = WSP(int, WS_TOPE); const int* TPOS = WSP(int, WS_TPOS); const float* GATE = WSP(float, WS_GATE); const unsigned char* Y = WSP(unsigned char, WS_Y);
    moe_tables(F, layer);
    const int gw = blockIdx.x * 8 + F.wave, NGW = F.G * 8, rpw = (T_LAT + NGW - 1) / NGW;
    const int r0 = T_CTX + gw * rpw, r1 = (r0 + rpw < T_ALL) ? r0 + rpw : T_ALL;
    f32x4 cG[4]; int cgb = -1;
#pragma unroll
    for (int j = 0; j < 4; ++j) cG[j] = (f32x4){0.f, 0.f, 0.f, 0.f};
    for (int rg = r0; rg < r1; rg += 2) {
        unsigned yv[2][4][4]; float g4[2][4]; f32x4 xv[2][4]; bool act[2];
#pragma unroll
        for (int q = 0; q < 2; ++q) { act[q] = rg + q < r1; const int row = act[q] ? rg + q : rg; int e4[4], p4[4];
            const int4 ev = *(const int4*)(TOPE + row * 4), pv = *(const int4*)(TPOS + row * 4); const f32x4 gv = *(const f32x4*)(GATE + row * 4);
            e4[0] = __builtin_amdgcn_readfirstlane(ev.x); e4[1] = __builtin_amdgcn_readfirstlane(ev.y); e4[2] = __builtin_amdgcn_readfirstlane(ev.z); e4[3] = __builtin_amdgcn_readfirstlane(ev.w);
            p4[0] = __builtin_amdgcn_readfirstlane(pv.x); p4[1] = __builtin_amdgcn_readfirstlane(pv.y); p4[2] = __builtin_amdgcn_readfirstlane(pv.z); p4[3] = __builtin_amdgcn_readfirstlane(pv.w);
            g4[q][0] = gv[0]; g4[q][1] = gv[1]; g4[q][2] = gv[2]; g4[q][3] = gv[3];
            const bf16_t* xd = XB + (size_t)row * D;
#pragma unroll
            for (int j2 = 0; j2 < 2; ++j2) { const u32x4 t = *(const u32x4*)(xd + 8 * lane + 512 * j2); xv[q][2 * j2] = (f32x4){bflo(t.x), bfhi(t.x), bflo(t.y), bfhi(t.y)}; xv[q][2 * j2 + 1] = (f32x4){bflo(t.z), bfhi(t.z), bflo(t.w), bfhi(t.w)}; }
            moe_y_load(F, Y, e4, p4, lane, yv[q]); }
#pragma unroll
        for (int q = 0; q < 2; ++q) { const int row = act[q] ? rg + q : rg; const int b9 = (row - T_CTX) >> 12; float* xd = XL + (size_t)(row - T_CTX) * D;
            f32x4 ys[4]; moe_y_sum(yv[q], g4[q], ys);
            if (b9 != cgb) { cgb = b9; const float* gf = MOD + ((size_t)layer * 9 + b9) * 6144 + 5 * 1024;
#pragma unroll
                for (int j = 0; j < 4; ++j) cG[j] = *(const f32x4*)(gf + PN_COL(j)); }
#pragma unroll
            for (int j = 0; j < 4; ++j) if (act[q]) *(f32x4*)(xd + PN_COL(j)) = xv[q][j] + cG[j] * ys[j]; }
    }
}

__device__ __forceinline__ void phase_convz(Frame& F, int jl, int row_lo, int row_hi) {
    const bf16_t* BG = WSP(bf16_t, WS_A0); const bf16_t* V = WSP(bf16_t, WS_A1); unsigned char* Z = WSP(unsigned char, WS_A2);
    const float* cw = inp(F, IN_CONV_W) + jl * 3 * 1024;
    const int lane = F.lane, gw = blockIdx.x * 8 + F.wave, NGW = F.G * 8, rpw = (row_hi - row_lo + NGW - 1) / NGW;
    const int r0 = row_lo + gw * rpw, r1 = (r0 + rpw < row_hi) ? r0 + rpw : row_hi;
    if (r0 >= r1) return;
    float wt[2][3][8];
#pragma unroll
    for (int j = 0; j < 2; ++j)
#pragma unroll
        for (int k = 0; k < 3; ++k) { const float* wp = cw + k * 1024 + 8 * lane + 512 * j; *(f32x4*)&wt[j][k][0] = *(const f32x4*)wp; *(f32x4*)&wt[j][k][4] = *(const f32x4*)(wp + 4); }
    u32x4 pa[2], pc[2];
#pragma unroll
    for (int j = 0; j < 2; ++j) { const int col = 8 * lane + 512 * j; pa[j] = *(const u32x4*)(V + (size_t)(r0 > 0 ? r0 - 1 : 0) * D + col); pc[j] = *(const u32x4*)(V + (size_t)r0 * D + col); }
    for (int rg = r0; rg < r1; rg += 4) {
        u32x4 nx[4][2], bgv[4][2];
#pragma unroll
        for (int q = 0; q < 4; ++q) { const int row = rg + q < r1 ? rg + q : r1 - 1, rn = row + 1 < T_ALL ? row + 1 : T_ALL - 1;
#pragma unroll
            for (int j = 0; j < 2; ++j) { const int col = 8 * lane + 512 * j; nx[q][j] = *(const u32x4*)(V + (size_t)rn * D + col); bgv[q][j] = *(const u32x4*)(BG + (size_t)row * D + col); } }
#pragma unroll
        for (int q = 0; q < 4; ++q) {
            const int row = rg + q;
            if (row < r1) {
                const bool isctx = row < T_CTX; const int t = isctx ? (row & 255) : ((row - T_CTX) & 4095); const int L = isctx ? 256 : 4096;
                const float mp = t != 0 ? 1.0f : 0.f, mn = t != L - 1 ? 1.0f : 0.f;
#pragma unroll
                for (int j = 0; j < 2; ++j) {
                    const u32x4 vm = q == 0 ? pa[j] : (q == 1 ? pc[j] : nx[q - 2][j]), v0 = q == 0 ? pc[j] : nx[q - 1][j], vp = nx[q][j], bg = bgv[q][j];
                    float zz[8];
#pragma unroll
                    for (int e = 0; e < 4; ++e) {
                        const float lo = bflo(bg[e]) * (wt[j][0][2 * e] * mp * bflo(vm[e]) + wt[j][1][2 * e] * bflo(v0[e]) + wt[j][2][2 * e] * mn * bflo(vp[e]));
                        const float hi = bfhi(bg[e]) * (wt[j][0][2 * e + 1] * mp * bfhi(vm[e]) + wt[j][1][2 * e + 1] * bfhi(v0[e]) + wt[j][2][2 * e + 1] * mn * bfhi(vp[e]));
                        zz[2 * e] = __builtin_amdgcn_fmed3f(lo, -448.f, 448.f); zz[2 * e + 1] = __builtin_amdgcn_fmed3f(hi, -448.f, 448.f);
                    }
                    u32x2 o; o.x = pk_fp8x4(zz[0], zz[1], zz[2], zz[3]); o.y = pk_fp8x4(zz[4], zz[5], zz[6], zz[7]);
                    *(u32x2*)(Z + (size_t)row * D + 8 * lane + 512 * j) = o;
                }
            }
        }
#pragma unroll
        for (int j = 0; j < 2; ++j) { pa[j] = nx[2][j]; pc[j] = nx[3][j]; }
    }
}

__device__ __forceinline__ float rope_apply(Frame& F, float x, int d, int row) {
    const int t = (row - T_CTX) & 4095; const int pos = (d < 32) ? (t >> 6) : (t & 63); const int f = d & 15;
    const float* rc = WSP(float, WS_ROPE); const float cs = rc[pos * 16 + f], sn = rc[1024 + pos * 16 + f];
    const float partner = shx(x, 16, d); const float rot = (d & 16) ? partner : -partner;
    return x * cs + rot * sn;
}
__device__ __forceinline__ void phase_mla_n1(Frame& F) {
    const bf16_t* DN = WSP(bf16_t, WS_A0); bf16_t* CQN = WSP(bf16_t, WS_A6); bf16_t* CKVN = WSP(bf16_t, WS_A6 + 26 * MiB); unsigned char* KR = WSP(unsigned char, WS_A6 + 44 * MiB);
    const float* qg = inp(F, IN_MLA_Q_NORM); const float* kvg = inp(F, IN_MLA_KV_NORM); const float* krg = inp(F, IN_MLA_KN_ROPE);
    const int lane = F.lane;
    f32x2 gq[3], gkv[2];
#pragma unroll
    for (int i = 0; i < 3; ++i) gq[i] = *(const f32x2*)(qg + 2 * lane + 128 * i);
#pragma unroll
    for (int i = 0; i < 2; ++i) gkv[i] = *(const f32x2*)(kvg + 2 * lane + 128 * i);
    const float gkr = krg[lane];
    const int gw = blockIdx.x * 8 + F.wave, NGW = F.G * 8, rpw = (T_ALL + NGW - 1) / NGW;
    const int r0 = gw * rpw, r1 = (r0 + rpw < T_ALL) ? r0 + rpw : T_ALL;
    for (int rg = r0; rg < r1; rg += 4) {
        f32x2 q[4][3], kv[4][2]; float kr[4]; bool act[4];
#pragma unroll
        for (int u = 0; u < 4; ++u) { act[u] = rg + u < r1; const int row = act[u] ? rg + u : rg; const bf16_t* dp = DN + (size_t)row * 768;
#pragma unroll
            for (int i = 0; i < 3; ++i) { const unsigned t = *(const unsigned*)(dp + 2 * lane + 128 * i); q[u][i] = (f32x2){bflo(t), bfhi(t)}; }
#pragma unroll
            for (int i = 0; i < 2; ++i) { const unsigned t = *(const unsigned*)(dp + 384 + 2 * lane + 128 * i); kv[u][i] = (f32x2){bflo(t), bfhi(t)}; }
            kr[u] = bf1(dp[640 + lane]); }
#pragma unroll
        for (int u = 0; u < 4; ++u) { const int row = act[u] ? rg + u : rg;
            float ss = 0.f;
#pragma unroll
            for (int i = 0; i < 3; ++i) ss += q[u][i].x * q[u][i].x + q[u][i].y * q[u][i].y;
            const float rq = 1.0f / sqrtf(wave_sum_fast(ss, lane) * (1.0f / 384.0f) + RMS_EPS);
            ss = 0.f;
#pragma unroll
            for (int i = 0; i < 2; ++i) ss += kv[u][i].x * kv[u][i].x + kv[u][i].y * kv[u][i].y;
            const float rkv = 1.0f / sqrtf(wave_sum_fast(ss, lane) * (1.0f / 256.0f) + RMS_EPS);
            const float rkr = 1.0f / sqrtf(wave_sum_fast(kr[u] * kr[u], lane) * (1.0f / 64.0f) + RMS_EPS);
            float krv = kr[u] * rkr * gkr;
            if (row >= T_CTX) krv = rope_apply(F, krv, lane, row);
            if (act[u]) {
#pragma unroll
                for (int i = 0; i < 3; ++i) *(unsigned*)(CQN + (size_t)row * 384 + 2 * lane + 128 * i) = cvt_pk_bf16(q[u][i].x * rq * gq[i].x, q[u][i].y * rq * gq[i].y);
#pragma unroll
                for (int i = 0; i < 2; ++i) *(unsigned*)(CKVN + (size_t)row * 256 + 2 * lane + 128 * i) = cvt_pk_bf16(kv[u][i].x * rkv * gkv[i].x, kv[u][i].y * rkv * gkv[i].y);
                KR[(size_t)row * 64 + lane] = (unsigned char)(pk_fp8x4(__builtin_amdgcn_fmed3f(krv, -448.f, 448.f), 0.f, 0.f, 0.f) & 0xffu); }
        }
    }
}
constexpr float QSCALE = 0.07216878364870322f * 1.4426950408889634f;
__device__ __forceinline__ float sum8(float v) {
    v += __int_as_float(__builtin_amdgcn_update_dpp(0, __float_as_int(v), 0xB1, 0xF, 0xF, true));
    v += __int_as_float(__builtin_amdgcn_update_dpp(0, __float_as_int(v), 0x4E, 0xF, 0xF, true));
    v += __int_as_float(__builtin_amdgcn_update_dpp(0, __float_as_int(v), 0x141, 0xF, 0xF, true));
    return v;
}
__device__ __forceinline__ float dpp_xor2(float v) { return __int_as_float(__builtin_amdgcn_update_dpp(0, __float_as_int(v), 0x4E, 0xF, 0xF, true)); }
__device__ __forceinline__ void phase_mla_n2(Frame& F) {
    const bf16_t* KNRAW = WSP(bf16_t, WS_A3); unsigned char* KN = WSP(unsigned char, WS_A4);
    const float* gk = inp(F, IN_MLA_KN_NOPE);
    const int lane = F.lane, hd = lane >> 3, sub = lane & 7;
    float gkv[16];
#pragma unroll
    for (int i = 0; i < 4; ++i) *(f32x4*)&gkv[4 * i] = *(const f32x4*)(gk + sub * 16 + 4 * i);
    const int gw = blockIdx.x * 8 + F.wave, NGW = F.G * 8, rpw = (T_ALL + NGW - 1) / NGW;
    const int r0 = gw * rpw, r1 = (r0 + rpw < T_ALL) ? r0 + rpw : T_ALL;
    for (int rg = r0; rg < r1; rg += 4) {
        u32x4 kn[4][2]; bool act[4];
#pragma unroll
        for (int u = 0; u < 4; ++u) { act[u] = rg + u < r1; const int row = act[u] ? rg + u : rg; const bf16_t* kp = KNRAW + (size_t)row * 1024 + hd * 128 + sub * 16;
            kn[u][0] = *(const u32x4*)(kp); kn[u][1] = *(const u32x4*)(kp + 8); }
#pragma unroll
        for (int u = 0; u < 4; ++u) { const int row = act[u] ? rg + u : rg;
            float k[16];
#pragma unroll
            for (int i = 0; i < 4; ++i) { k[2 * i] = bflo(kn[u][0][i]); k[2 * i + 1] = bfhi(kn[u][0][i]); k[8 + 2 * i] = bflo(kn[u][1][i]); k[8 + 2 * i + 1] = bfhi(kn[u][1][i]); }
            float sk = 0.f;
#pragma unroll
            for (int i = 0; i < 16; ++i) sk += k[i] * k[i];
            const float rk = 1.0f / sqrtf(sum8(sk) * (1.0f / 128.0f) + RMS_EPS);
            if (act[u]) { unsigned char* ko = KN + (size_t)row * 1024 + hd * 128 + sub * 16; u32x4 k0;
#pragma unroll
                for (int i = 0; i < 4; ++i) k0[i] = pk_fp8x4(__builtin_amdgcn_fmed3f(k[4 * i] * rk * gkv[4 * i], -448.f, 448.f), __builtin_amdgcn_fmed3f(k[4 * i + 1] * rk * gkv[4 * i + 1], -448.f, 448.f),
                                                           __builtin_amdgcn_fmed3f(k[4 * i + 2] * rk * gkv[4 * i + 2], -448.f, 448.f), __builtin_amdgcn_fmed3f(k[4 * i + 3] * rk * gkv[4 * i + 3], -448.f, 448.f));
                *(u32x4*)(ko) = k0; }
        }
    }
}

constexpr int AT_KSTR = 208, AT_VSTR = 80, AT_KBYTES = 128 * AT_KSTR, AT_VSUB = 128 * AT_VSTR, AT_VBYTES = 2 * AT_VSUB;
#define MFMA8U(a, b, c) __builtin_amdgcn_mfma_scale_f32_32x32x64_f8f6f4(a, b, c, 0, 0, 0, 0x7f7f7f7f, 0, 0x7f7f7f7f)
#define MFMA8S(a, b, c) __builtin_amdgcn_mfma_scale_f32_32x32x64_f8f6f4(a, b, c, 0, 0, 0, 0x7f7f7f7f, 0, 0x7b7b7b7b)
__device__ __forceinline__ float c8(float x) { return __builtin_amdgcn_fmed3f(x, -448.f, 448.f); }
__device__ __forceinline__ void phase_attn(Frame& F, bool ctx_queries) {
    const bf16_t* Q = WSP(bf16_t, WS_A1);
    const float* gqn = inp(F, IN_MLA_QN_NOPE); const float* gqr = inp(F, IN_MLA_QN_ROPE); const float* ropet = WSP(float, WS_ROPE);
    const unsigned char* KN = WSP(unsigned char, WS_A4); const unsigned char* KR = WSP(unsigned char, WS_A6 + 44 * MiB); const unsigned char* VT = WSP(unsigned char, WS_A5);
    unsigned char* O = WSP(unsigned char, WS_A6 + 50 * MiB);
    const int tid = F.tid, lane = F.lane, w = F.wave, r = lane & 31, hh = lane >> 5;
    LAS unsigned char* KB = F.lds; LAS unsigned char* VB = F.lds + 2 * AT_KBYTES;
    const int NU = ctx_queries ? 1024 + 64 : 1024;
    for (int L = F.vcu; L < NU; L += F.G) {
        int b, h, qrow0, ntile; bool lat;
        if (L < 1024) { const int bh = L >> 4, qb = L & 15; b = bh >> 3; h = bh & 7; qrow0 = T_CTX + b * SEQ + qb * 256; ntile = 34; lat = true; }
        else { const int Lc = L - 1024; b = Lc >> 3; h = Lc & 7; qrow0 = b * CTXL; ntile = 2; lat = false; }
        const int qrow = qrow0 + 32 * w + r;
        v8i Qf[3];
        {
            u32x4 qraw[12]; float ssn = 0.f, ssr = 0.f;
#pragma unroll
            for (int q = 0; q < 12; ++q) { qraw[q] = *(const u32x4*)(Q + (size_t)qrow * 1536 + h * 192 + 64 * (q >> 2) + 32 * hh + 8 * (q & 3));
                float sq = 0.f;
#pragma unroll
                for (int i = 0; i < 4; ++i) { const float lo = bflo(qraw[q][i]), hi = bfhi(qraw[q][i]); sq += lo * lo + hi * hi; }
                if (q < 8) ssn += sq; else ssr += sq; }
            ssn = xsum32(ssn); ssr = xsum32(ssr);
            const float rn = (16.0f * QSCALE) / sqrtf(ssn * (1.0f / 128.0f) + RMS_EPS), rr = 1.0f / sqrtf(ssr * (1.0f / 64.0f) + RMS_EPS);
#pragma unroll
            for (int ks = 0; ks < 2; ++ks)
#pragma unroll
                for (int c = 0; c < 4; ++c) { const f32x4 g0 = *(const f32x4*)(gqn + 64 * ks + 32 * hh + 8 * c), g1 = *(const f32x4*)(gqn + 64 * ks + 32 * hh + 8 * c + 4); const u32x4 qr = qraw[4 * ks + c];
                    Qf[ks][2 * c] = (int)pk_fp8x4(c8(bflo(qr.x) * rn * g0[0]), c8(bfhi(qr.x) * rn * g0[1]), c8(bflo(qr.y) * rn * g0[2]), c8(bfhi(qr.y) * rn * g0[3]));
                    Qf[ks][2 * c + 1] = (int)pk_fp8x4(c8(bflo(qr.z) * rn * g1[0]), c8(bfhi(qr.z) * rn * g1[1]), c8(bflo(qr.w) * rn * g1[2]), c8(bfhi(qr.w) * rn * g1[3])); }
            const int tq = (qrow - T_CTX) & 4095, pos = hh == 0 ? (tq >> 6) : (tq & 63);
#pragma unroll
            for (int c = 0; c < 2; ++c) {
                float x1[8], x2[8], gg1[8], gg2[8], cs[8], sn[8];
                *(f32x4*)&gg1[0] = *(const f32x4*)(gqr + 32 * hh + 8 * c); *(f32x4*)&gg1[4] = *(const f32x4*)(gqr + 32 * hh + 8 * c + 4);
                *(f32x4*)&gg2[0] = *(const f32x4*)(gqr + 32 * hh + 16 + 8 * c); *(f32x4*)&gg2[4] = *(const f32x4*)(gqr + 32 * hh + 16 + 8 * c + 4);
                *(f32x4*)&cs[0] = *(const f32x4*)(ropet + pos * 16 + 8 * c); *(f32x4*)&cs[4] = *(const f32x4*)(ropet + pos * 16 + 8 * c + 4);
                *(f32x4*)&sn[0] = *(const f32x4*)(ropet + 1024 + pos * 16 + 8 * c); *(f32x4*)&sn[4] = *(const f32x4*)(ropet + 1024 + pos * 16 + 8 * c + 4);
#pragma unroll
                for (int i = 0; i < 4; ++i) { x1[2 * i] = bflo(qraw[8 + c][i]) * rr * gg1[2 * i]; x1[2 * i + 1] = bfhi(qraw[8 + c][i]) * rr * gg1[2 * i + 1];
                    x2[2 * i] = bflo(qraw[10 + c][i]) * rr * gg2[2 * i]; x2[2 * i + 1] = bfhi(qraw[10 + c][i]) * rr * gg2[2 * i + 1]; }
#pragma unroll
                for (int j = 0; j < 8; ++j) {
                    float a0 = x1[j], b0 = x2[j];
                    if (lat) { const float na = a0 * cs[j] - b0 * sn[j], nb = b0 * cs[j] + a0 * sn[j]; a0 = na; b0 = nb; }
                    x1[j] = c8(a0 * (16.0f * QSCALE)); x2[j] = c8(b0 * (16.0f * QSCALE)); }
                Qf[2][2 * c] = (int)pk_fp8x4(x1[0], x1[1], x1[2], x1[3]); Qf[2][2 * c + 1] = (int)pk_fp8x4(x1[4], x1[5], x1[6], x1[7]);
                Qf[2][4 + 2 * c] = (int)pk_fp8x4(x2[0], x2[1], x2[2], x2[3]); Qf[2][4 + 2 * c + 1] = (int)pk_fp8x4(x2[4], x2[5], x2[6], x2[7]);
            }
        }
        u32x4 kreg[3], vreg[2];
        auto tile_row0 = [&](int t) { return lat ? (t < 32 ? T_CTX + b * SEQ + 128 * t : b * CTXL + 128 * (t - 32)) : b * CTXL + 128 * t; };
        const unsigned kofs0 = (unsigned)((tid >> 3) * 1024 + 16 * (tid & 7)), vofs0 = (unsigned)(tid * 16);
        const unsigned kl0 = (unsigned)((tid >> 3) * AT_KSTR + (tid & 7) * 16), kl2 = (unsigned)((tid >> 2) * AT_KSTR + 128 + (tid & 3) * 16);
        const unsigned vl0 = (unsigned)((tid >> 2) * AT_VSTR + (tid & 3) * 16);
#define AT_LOAD(t) do { const int kr0_ = tile_row0(t); const unsigned char* knu_ = KN + (size_t)kr0_ * 1024 + h * 128; const unsigned char* kru_ = KR + (size_t)kr0_ * 64; const unsigned char* vtu_ = VT + ((size_t)(kr0_ >> 6) * 1024 + h * 128) * 64; \
        kreg[0] = *(const u32x4*)(knu_ + kofs0); kreg[1] = *(const u32x4*)(knu_ + kofs0 + 64u * 1024u); kreg[2] = *(const u32x4*)(kru_ + vofs0); \
        vreg[0] = *(const u32x4*)(vtu_ + vofs0); vreg[1] = *(const u32x4*)(vtu_ + vofs0 + 65536u); } while (0)
#define AT_STORE(buf) do { LAS unsigned char* kd_ = KB + (buf) * AT_KBYTES; LAS unsigned char* vd_ = VB + (buf) * AT_VBYTES; \
        *(LAS u32x4*)(kd_ + kl0) = kreg[0]; *(LAS u32x4*)(kd_ + kl0 + 64 * AT_KSTR) = kreg[1]; *(LAS u32x4*)(kd_ + kl2) = kreg[2]; \
        *(LAS u32x4*)(vd_ + vl0) = vreg[0]; *(LAS u32x4*)(vd_ + AT_VSUB + vl0) = vreg[1]; } while (0)
        __syncthreads();
        AT_LOAD(0); AT_STORE(0);
        __syncthreads();
        int first = 1; asm volatile("" : "+s"(first));
        float m_run = 0.f, l_run = 0.f;
        f32x16 o[4];
#pragma unroll
        for (int vb = 0; vb < 4; ++vb)
#pragma unroll
            for (int i = 0; i < 16; ++i) o[vb][i] = 0.f;
        for (int t = 0; t < ntile; ++t) {
            const int buf = t & 1;
#pragma unroll
          for (int sub = 0; sub < 2; ++sub) {
            f32x16 s0, s1;
            { const float nm = -m_run;
#pragma unroll
              for (int i = 0; i < 16; ++i) { s0[i] = nm; s1[i] = nm; } }
            {
                const LAS unsigned char* kb = KB + buf * AT_KBYTES + (64 * sub + r) * AT_KSTR + hh * 32;
                v8i ka[2][2];
#define AT_LDK(dst, ks_) do { _Pragma("unroll") for (int kb_ = 0; kb_ < 2; ++kb_) { const u32x4 lo_ = *(const LAS u32x4*)(kb + kb_ * 32 * AT_KSTR + (ks_) * 64), hi_ = *(const LAS u32x4*)(kb + kb_ * 32 * AT_KSTR + (ks_) * 64 + 16); \
        dst[kb_] = (v8i){(int)lo_.x, (int)lo_.y, (int)lo_.z, (int)lo_.w, (int)hi_.x, (int)hi_.y, (int)hi_.z, (int)hi_.w}; } } while (0)
                AT_LDK(ka[0], 0); AT_LDK(ka[1], 1);
#pragma unroll
                for (int ks = 0; ks < 3; ++ks) {
                    __builtin_amdgcn_sched_barrier(0);
                    s0 = MFMA8S(ka[ks & 1][0], Qf[ks], s0); s1 = MFMA8S(ka[ks & 1][1], Qf[ks], s1);
                    if (ks == 0) AT_LDK(ka[0], 2);
                }
                __builtin_amdgcn_sched_barrier(0);
#undef AT_LDK
            }
            if (sub == 0 && t + 1 < ntile) AT_LOAD(t + 1);
            v8i va[4];
            { const LAS unsigned char* vbp = VB + buf * AT_VBYTES + sub * AT_VSUB + r * AT_VSTR + hh * 32;
#pragma unroll
              for (int vb = 0; vb < 4; ++vb) { const u32x4 lo_ = *(const LAS u32x4*)(vbp + vb * 32 * AT_VSTR), hi_ = *(const LAS u32x4*)(vbp + vb * 32 * AT_VSTR + 16);
                  va[vb] = (v8i){(int)lo_.x, (int)lo_.y, (int)lo_.z, (int)lo_.w, (int)hi_.x, (int)hi_.y, (int)hi_.z, (int)hi_.w}; } }
            __builtin_amdgcn_sched_barrier(0);
            float mx = s0[0], mxb = s1[0];
#pragma unroll
            for (int i = 1; i < 16; ++i) { mx = fmaxf(mx, s0[i]); mxb = fmaxf(mxb, s1[i]); }
            mx = fmaxf(mx, mxb);
            mx = xmax32(mx);
            if (first | (int)(__builtin_amdgcn_ballot_w64(mx > 8.0f) != 0ull)) {
                const float d = (first || mx > 8.0f) ? mx - 6.0f : 0.f, alpha = first ? 0.f : __builtin_amdgcn_exp2f(-d);
                first = 0;
                m_run += d; l_run *= alpha;
#pragma unroll
                for (int i = 0; i < 16; ++i) { s0[i] -= d; s1[i] -= d; }
#pragma unroll
                for (int vb = 0; vb < 4; ++vb)
#pragma unroll
                    for (int i = 0; i < 16; ++i) o[vb][i] *= alpha;
            }
            float ls = 0.f, lsb = 0.f;
#pragma unroll
            for (int i = 0; i < 16; ++i) { s0[i] = __builtin_amdgcn_exp2f(s0[i]); s1[i] = __builtin_amdgcn_exp2f(s1[i]); ls += s0[i]; lsb += s1[i]; }
            l_run += ls + lsb;
            v8i pf;
#pragma unroll
            for (int i = 0; i < 4; ++i) { pf[i] = (int)pk_fp8x4(s0[4 * i], s0[4 * i + 1], s0[4 * i + 2], s0[4 * i + 3]); pf[4 + i] = (int)pk_fp8x4(s1[4 * i], s1[4 * i + 1], s1[4 * i + 2], s1[4 * i + 3]); }
            __builtin_amdgcn_sched_barrier(0);
#pragma unroll
            for (int vb = 0; vb < 4; ++vb) o[vb] = MFMA8U(va[vb], pf, o[vb]);
            __builtin_amdgcn_sched_barrier(0);
          }
            if (t + 1 < ntile) AT_STORE(buf ^ 1);
            __syncthreads();
        }
        const float lt = xsum32(l_run), inv = 1.0f / lt;
        unsigned char* op = O + (size_t)qrow * 1024 + h * 128 + 4 * hh;
#pragma unroll
        for (int vb = 0; vb < 4; ++vb)
#pragma unroll
            for (int g = 0; g < 4; ++g) *(unsigned*)(op + 32 * vb + 8 * g) = pk_fp8x4(o[vb][4 * g] * inv, o[vb][4 * g + 1] * inv, o[vb][4 * g + 2] * inv, o[vb][4 * g + 3] * inv);
#undef AT_LOAD
#undef AT_STORE
    }
}

__device__ __forceinline__ int ml_block_of_chunk(int dir, int ci) { return dir == 0 ? ci : (ci < 4 ? 3 - ci : 71 - ci); }
__device__ __forceinline__ int ml_rowbase(int b, int j) { return j < 4 ? b * CTXL + 64 * j : T_CTX + b * SEQ + 64 * (j - 4); }
__device__ __forceinline__ void phase_ml_scan_gates(Frame& F) {
    const float* G32 = WSP(float, WS_G32);
    float* SU = WSP(float, WS_SCU); float* SMU = WSP(float, WS_SCMU); float* SB = WSP(float, WS_SCB); float* CHM = WSP(float, WS_CHM); float* CHMU = CHM + 16384;
    volatile LAS float* sbl = (volatile LAS float*)(F.MISC + MI_SCR); volatile LAS float* sM = sbl + 72; volatile LAS float* smc = sM + 72;
    const int lane = F.lane;
    for (int chain = (F.G >= 256) ? (int)blockIdx.x - 128 : (int)blockIdx.x; chain >= 0 && chain < 128; chain += F.G) {
        const int dir = chain >> 6, b = (chain >> 3) & 7, h = chain & 7;
        const int gi = dir * 16 + h, gf = dir * 16 + 8 + h;
        float bb[9], uu[9], MM[9];
#pragma unroll
        for (int k = 0; k < 9; ++k) {
            const int ci = F.wave + 8 * k; bb[k] = 0.f; uu[k] = 0.f; MM[k] = 0.f;
            if (ci < NCHUNK) {
                const int rb = ml_rowbase(b, ml_block_of_chunk(dir, ci)); const int row = dir ? rb + 63 - lane : rb + lane;
                const float iv = G32[(size_t)row * 32 + gi]; float bsum = G32[(size_t)row * 32 + gf];
#pragma unroll
                for (int o = 1; o < 64; o <<= 1) { const float t = shup(bsum, o, lane); if (lane >= o) bsum += t; }
                const float u = iv - bsum; float M = u;
#pragma unroll
                for (int o = 1; o < 64; o <<= 1) { const float t = shup(M, o, lane); if (lane >= o) M = fmaxf(M, t); }
                bb[k] = bsum; uu[k] = u; MM[k] = M;
                if (lane == 63) { sbl[ci] = bsum; sM[ci] = M; }
            }
        }
        __syncthreads();
        if (F.tid == 0) { float m = 0.f; for (int ci = 0; ci < NCHUNK; ++ci) { smc[ci] = m; m = sbl[ci] + fmaxf(m, sM[ci]); } }
        __syncthreads();
#pragma unroll
        for (int k = 0; k < 9; ++k) {
            const int ci = F.wave + 8 * k;
            if (ci < NCHUNK) {
                const int rb = ml_rowbase(b, ml_block_of_chunk(dir, ci)); const int row = dir ? rb + 63 - lane : rb + lane;
                const float mc = smc[ci]; const size_t o = ((size_t)(dir * 8 + h)) * T_ALL + row;
                SU[o] = uu[k]; SMU[o] = fmaxf(mc, MM[k]); SB[o] = bb[k];
                if (lane == 0) { CHM[chain * NCHUNK + ci] = mc; CHMU[chain * NCHUNK + ci] = fmaxf(mc, sM[ci]); }
            }
        }
        __syncthreads();
    }
}
constexpr int MS_STR = 144, MS_TILE = 64 * MS_STR, MS_STEP = 2 * MS_TILE + 256, MS_GRP = 2 * MS_STEP;
__device__ __forceinline__ void phase_ml_state(Frame& F) {
    const bf16_t* KTV = WSP(bf16_t, WS_A2);
    const float* SU = WSP(float, WS_SCU); const float* CHM = WSP(float, WS_CHM); const float* CHMU = CHM + 16384;
    bf16_t* CST = WSP(bf16_t, WS_A5); float* NST = WSP(float, WS_NST);
    const int tid = F.tid, lane = F.lane, w = F.wave, fr = lane & 15, fq = lane >> 4, ti = w >> 1, tj0 = 2 * (w & 1);
    LAS unsigned char* L = F.lds;
    bf16x8 ones; { u32x4 t = (u32x4){0x3f803f80u, 0x3f803f80u, 0x3f803f80u, 0x3f803f80u}; ones = __builtin_bit_cast(bf16x8, t); }
    const unsigned pl = (unsigned)((tid >> 3) * MS_STR + (tid & 7) * 16);
    for (int unit = blockIdx.x; unit < 256; unit += F.G) {
        const int chain = unit >> 1, vh = unit & 1, dir = chain >> 6, b = (chain >> 3) & 7, h = chain & 7;
        f32x4 acc[2] = {(f32x4){0.f, 0.f, 0.f, 0.f}, (f32x4){0.f, 0.f, 0.f, 0.f}}, nacc = (f32x4){0.f, 0.f, 0.f, 0.f};
        const bf16_t* kbase = KTV + (size_t)(h * 64) * 64 + tid * 8; const bf16_t* vbase = KTV + (size_t)(512 + h * 128 + vh * 64) * 64 + tid * 8;
        const float* ubase = SU + (size_t)(dir * 8 + h) * T_ALL + (tid & 63);
        u32x4 sk[2], sv[2]; float su = 0.f, mcn[2], mun[2], mcc[2], muc[2];
#define MS_LOAD(g_) do { _Pragma("unroll") for (int s_ = 0; s_ < 2; ++s_) { const int ci_ = 2 * (g_) + s_, rb_ = ml_rowbase(b, ml_block_of_chunk(dir, ci_)); const size_t bo_ = (size_t)(rb_ >> 6) * (1536 * 64); \
            sk[s_] = *(const u32x4*)(kbase + bo_); sv[s_] = *(const u32x4*)(vbase + bo_); if ((tid >> 6) == s_) su = ubase[rb_]; \
            mcn[s_] = CHM[chain * NCHUNK + ci_]; mun[s_] = CHMU[chain * NCHUNK + ci_]; } } while (0)
#define MS_STORE(buf_) do { _Pragma("unroll") for (int s_ = 0; s_ < 2; ++s_) { LAS unsigned char* d_ = L + (buf_) * MS_GRP + s_ * MS_STEP; \
            *(LAS u32x4*)(d_ + pl) = sk[s_]; *(LAS u32x4*)(d_ + MS_TILE + pl) = sv[s_]; if ((tid >> 6) == s_) *(LAS float*)(d_ + 2 * MS_TILE + (tid & 63) * 4) = su; } } while (0)
        __syncthreads();
        MS_LOAD(0); MS_STORE(0); mcc[0] = mcn[0]; mcc[1] = mcn[1]; muc[0] = mun[0]; muc[1] = mun[1];
        MS_LOAD(1);
        __syncthreads();
        for (int g = 0; g < NCHUNK / 2; ++g) {
            const LAS unsigned char* gb = L + (g & 1) * MS_GRP;
#pragma unroll
            for (int s = 0; s < 2; ++s) {
                const int ci = 2 * g + s; const float mu63 = muc[s], alpha = fast_exp(mcc[s] - mu63);
                const LAS unsigned char* sb = gb + s * MS_STEP;
                u32x4 kav[2]; f32x4 u0[2], u1[2]; bf16x8 b0[2], b1[2];
#pragma unroll
                for (int ks = 0; ks < 2; ++ks) { kav[ks] = *(const LAS u32x4*)(sb + (16 * ti + fr) * MS_STR + (32 * ks + 8 * fq) * 2);
                    b0[ks] = *(const LAS bf16x8*)(sb + MS_TILE + (16 * tj0 + fr) * MS_STR + (32 * ks + 8 * fq) * 2); b1[ks] = *(const LAS bf16x8*)(sb + MS_TILE + (16 * tj0 + 16 + fr) * MS_STR + (32 * ks + 8 * fq) * 2);
                    u0[ks] = *(const LAS f32x4*)(sb + 2 * MS_TILE + (32 * ks + 8 * fq) * 4); u1[ks] = *(const LAS f32x4*)(sb + 2 * MS_TILE + (32 * ks + 8 * fq) * 4 + 16); }
                { bf16_t* cp = CST + ((size_t)chain * NCHUNK + ci) * 8192 + ((vh * 4 + tj0) * 4 + ti) * 256 + fr * 16 + 4 * fq;
                  u32x2 s0; s0.x = cvt_pk_bf16(acc[0][0], acc[0][1]); s0.y = cvt_pk_bf16(acc[0][2], acc[0][3]); *(u32x2*)cp = s0;
                  u32x2 s1; s1.x = cvt_pk_bf16(acc[1][0], acc[1][1]); s1.y = cvt_pk_bf16(acc[1][2], acc[1][3]); *(u32x2*)(cp + 4 * 256) = s1;
                  if (vh == 0 && (w & 1) == 0 && fr == 0) *(f32x4*)(NST + ((size_t)chain * NCHUNK + ci) * 64 + 16 * ti + 4 * fq) = nacc; }
                acc[0] = acc[0] * alpha; acc[1] = acc[1] * alpha; nacc = nacc * alpha;
#pragma unroll
                for (int ks = 0; ks < 2; ++ks) {
                    const u32x4 ka = kav[ks]; u32x4 aw;
                    aw.x = cvt_pk_bf16(bflo(ka.x) * fast_exp(u0[ks][0] - mu63), bfhi(ka.x) * fast_exp(u0[ks][1] - mu63));
                    aw.y = cvt_pk_bf16(bflo(ka.y) * fast_exp(u0[ks][2] - mu63), bfhi(ka.y) * fast_exp(u0[ks][3] - mu63));
                    aw.z = cvt_pk_bf16(bflo(ka.z) * fast_exp(u1[ks][0] - mu63), bfhi(ka.z) * fast_exp(u1[ks][1] - mu63));
                    aw.w = cvt_pk_bf16(bflo(ka.w) * fast_exp(u1[ks][2] - mu63), bfhi(ka.w) * fast_exp(u1[ks][3] - mu63));
                    const bf16x8 A = __builtin_bit_cast(bf16x8, aw);
                    acc[0] = MFMA16(A, b0[ks], acc[0]); acc[1] = MFMA16(A, b1[ks], acc[1]); nacc = MFMA16(A, ones, nacc); }
            }
            if (g + 1 < NCHUNK / 2) { MS_STORE((g + 1) & 1); mcc[0] = mcn[0]; mcc[1] = mcn[1]; muc[0] = mun[0]; muc[1] = mun[1]; }
            if (g + 2 < NCHUNK / 2) MS_LOAD(g + 2);
            __syncthreads();
        }
#undef MS_LOAD
#undef MS_STORE
    }
}
constexpr int MO_S144 = 144, MO_S136 = 136, MO_S264 = 264;
constexpr int MO_K = 0, MO_Q = 64 * MO_S144, MO_V = 2 * 64 * MO_S144, MO_C0 = MO_V + 128 * MO_S136, MO_C1 = MO_C0 + 128 * MO_S144, MO_O = MO_C1 + 128 * MO_S144, MO_SM = MO_O + 64 * MO_S264, MO_END = MO_SM + 2048 + 64;
__device__ __forceinline__ void phase_ml_out(Frame& F) {
    const bf16_t* Qb = WSP(bf16_t, WS_A0); const bf16_t* Kb = Qb + (size_t)T_ALL * 512; const bf16_t* Ob = WSP(bf16_t, WS_A1);
    const bf16_t* KTV = WSP(bf16_t, WS_A2);
    const float* SU = WSP(float, WS_SCU); const float* SMU = WSP(float, WS_SCMU); const float* SB = WSP(float, WS_SCB); const float* CHM = WSP(float, WS_CHM);
    const bf16_t* CST = WSP(bf16_t, WS_A5); const float* NST = WSP(float, WS_NST);
    unsigned char* HN = WSP(unsigned char, WS_A3); const float* ng = inp(F, IN_ML_NORM);
    volatile LAS float* part = (volatile LAS float*)(F.MISC + MI_SCR);
    LAS unsigned char* L = F.lds;
    const LAS float* SM = (const LAS float*)(F.lds + MO_SM);
    const int tid = F.tid, lane = F.lane, w = F.wave, r = lane & 31, hh = lane >> 5, tb = w & 1, vb = w >> 1;
    const int srow = tid >> 3, sc = tid & 7, orow = tid >> 4, oc = tid & 15;
    const int sq = tid >> 7, sdir = (tid >> 6) & 1, si = tid & 63;
    u32x4 stg[10]; float ssm, scm;
#define MO_G(T, off_) (*(const T*)(F.ws + (size_t)(unsigned)(off_)))
#define MO_LOAD(unit_) do { const int bh_ = (unit_) / NCHUNK, j_ = (unit_) % NCHUNK, b_ = bh_ >> 3, h_ = bh_ & 7, rb_ = ml_rowbase(b_, j_); \
        const int cf_ = ((0 * 8 + b_) * 8 + h_) * NCHUNK + j_, cb_ = ((1 * 8 + b_) * 8 + h_) * NCHUNK + (j_ < 4 ? 3 - j_ : 71 - j_); \
        const unsigned qk_ = (unsigned)(((rb_ + srow) * 512 + h_ * 64 + 8 * sc) * 2); \
        stg[0] = MO_G(u32x4, (unsigned)WS_A0 + (unsigned)T_ALL * 1024u + qk_); stg[1] = MO_G(u32x4, (unsigned)WS_A0 + qk_); \
        const unsigned vt_ = (unsigned)WS_A2 + (unsigned)((((rb_ >> 6) * 1536 + 512 + h_ * 128) * 64 + tid * 8) * 2); stg[2] = MO_G(u32x4, vt_); stg[3] = MO_G(u32x4, vt_ + 8192u); \
        const unsigned c0_ = (unsigned)WS_A5 + (unsigned)(cf_ * 16384 + tid * 16), c1_ = (unsigned)WS_A5 + (unsigned)(cb_ * 16384 + tid * 16); \
        stg[4] = MO_G(u32x4, c0_); stg[5] = MO_G(u32x4, c0_ + 8192u); stg[6] = MO_G(u32x4, c1_); stg[7] = MO_G(u32x4, c1_ + 8192u); \
        const unsigned ob_ = (unsigned)WS_A1 + (unsigned)(((rb_ + orow) * 1024 + h_ * 128 + 8 * oc) * 2); stg[8] = MO_G(u32x4, ob_); stg[9] = MO_G(u32x4, ob_ + 32u * 2048u); \
        { const unsigned so_ = (unsigned)(((sdir * 8 + h_) * T_ALL + rb_ + si) * 4); const int cc_ = sdir ? cb_ : cf_; \
          const unsigned sa_ = sq < 3 ? (unsigned)WS_SCU + (unsigned)sq * (unsigned)(WS_SCMU - WS_SCU) + so_ : (unsigned)WS_NST + (unsigned)((cc_ * 64 + si) * 4); \
          ssm = MO_G(float, sa_); scm = MO_G(float, (unsigned)WS_CHM + (unsigned)((lane & 1 ? cb_ : cf_) * 4)); } } while (0)
#define MO_STORE() do { *(LAS u32x4*)(L + MO_K + srow * MO_S144 + sc * 16) = stg[0]; *(LAS u32x4*)(L + MO_Q + srow * MO_S144 + sc * 16) = stg[1]; \
        { LAS unsigned char* d_ = L + MO_V + srow * MO_S136 + sc * 16; *(LAS u32x2*)d_ = (u32x2){stg[2].x, stg[2].y}; *(LAS u32x2*)(d_ + 8) = (u32x2){stg[2].z, stg[2].w}; \
          d_ += 64 * MO_S136; *(LAS u32x2*)d_ = (u32x2){stg[3].x, stg[3].y}; *(LAS u32x2*)(d_ + 8) = (u32x2){stg[3].z, stg[3].w}; } \
        { int t_ = tid; asm volatile("" : "+v"(t_)); const int cpos_ = (16 * (t_ >> 7) + ((t_ & 31) >> 1)) * MO_S144 + (16 * ((t_ >> 5) & 3) + 8 * (t_ & 1)) * 2;     \
          *(LAS u32x4*)(L + MO_C0 + cpos_) = stg[4]; *(LAS u32x4*)(L + MO_C0 + 64 * MO_S144 + cpos_) = stg[5]; \
          *(LAS u32x4*)(L + MO_C1 + cpos_) = stg[6]; *(LAS u32x4*)(L + MO_C1 + 64 * MO_S144 + cpos_) = stg[7]; } \
        { LAS unsigned char* d_ = L + MO_O + orow * MO_S264 + oc * 16; *(LAS u32x2*)d_ = (u32x2){stg[8].x, stg[8].y}; *(LAS u32x2*)(d_ + 8) = (u32x2){stg[8].z, stg[8].w}; \
          d_ += 32 * MO_S264; *(LAS u32x2*)d_ = (u32x2){stg[9].x, stg[9].y}; *(LAS u32x2*)(d_ + 8) = (u32x2){stg[9].z, stg[9].w}; } \
        *(LAS float*)(L + MO_SM + tid * 4) = ssm; if (tid < 2) *(LAS float*)(L + MO_SM + 2048 + tid * 4) = scm; } while (0)
    int unit = F.vcu;
    if (unit < 64 * NCHUNK) MO_LOAD(unit);
    for (; unit < 64 * NCHUNK; unit += F.G) {
        __syncthreads();
        MO_STORE();
        __syncthreads();
        if (unit + F.G < 64 * NCHUNK) MO_LOAD(unit + F.G);
        const int bh = unit / NCHUNK, j = unit % NCHUNK, b = bh >> 3, h = bh & 7;
        const int rb = ml_rowbase(b, j), trow = rb + 32 * tb + r, tt = 32 * tb + r;
        bf16x8 qf[4];
#pragma unroll
        for (int ks = 0; ks < 4; ++ks) qf[ks] = *(const LAS bf16x8*)(L + MO_Q + (32 * tb + r) * MO_S144 + (16 * ks + 8 * hh) * 2);
        f32x16 sacc[2];
#pragma unroll
        for (int kb = 0; kb < 2; ++kb) {
#pragma unroll
            for (int i = 0; i < 16; ++i) sacc[kb][i] = 0.f;
#pragma unroll
            for (int ks = 0; ks < 4; ++ks) { const bf16x8 ka = *(const LAS bf16x8*)(L + MO_K + (32 * kb + r) * MO_S144 + (16 * ks + 8 * hh) * 2); sacc[kb] = MFMA32(ka, qf[ks], sacc[kb]); }
        }
        f32x16 hsum;
#pragma unroll
        for (int i = 0; i < 16; ++i) hsum[i] = 0.f;
#pragma unroll
        for (int dir = 0; dir < 2; ++dir) {
            const float mu_t = SM[128 + dir * 64 + tt], b_t = SM[256 + dir * 64 + tt], mc = SM[512 + dir];
            const float a_t = fast_exp(mc - mu_t), e_t = fast_exp(-(b_t + mu_t));
            bf16x8 pf[2][2]; float den = 0.f;
#pragma unroll
            for (int kb = 0; kb < 2; ++kb) { f32x16 P;
#pragma unroll
                for (int g = 0; g < 4; ++g) { const int sbase = 32 * kb + 8 * g + 4 * hh; const f32x4 u4 = *(const LAS f32x4*)(SM + dir * 64 + sbase);
#pragma unroll
                    for (int ii = 0; ii < 4; ++ii) { const int sp = sbase + ii; const bool valid = dir == 0 ? (sp <= tt) : (sp >= tt);
                        const float wgt = valid ? fast_exp(u4[ii] - mu_t) : 0.f; const float p = sacc[kb][4 * g + ii] * wgt; den += p; P[4 * g + ii] = p; } }
                pf[kb][0] = pack8(P, 0); pf[kb][1] = pack8(P, 1); }
            den = xsum32(den);
            float qn = 0.f;
#pragma unroll
            for (int ks = 0; ks < 4; ++ks) { const LAS float* np = SM + 384 + dir * 64 + 16 * ks + 8 * hh; const f32x4 n0 = *(const LAS f32x4*)np, n1 = *(const LAS f32x4*)(np + 4);
                const u32x4 qq = __builtin_bit_cast(u32x4, qf[ks]);
                qn += bflo(qq.x) * n0[0] + bfhi(qq.x) * n0[1] + bflo(qq.y) * n0[2] + bfhi(qq.y) * n0[3] + bflo(qq.z) * n1[0] + bfhi(qq.z) * n1[1] + bflo(qq.w) * n1[2] + bfhi(qq.w) * n1[3]; }
            qn = xsum32(qn);
            const float denf = den + a_t * qn, inv = 1.0f / fmaxf(fabsf(denf), e_t);
            f32x16 pv, qc;
#pragma unroll
            for (int i = 0; i < 16; ++i) { pv[i] = 0.f; qc[i] = 0.f; }
            const LAS unsigned char* vtp = L + MO_V + (32 * vb + r) * MO_S136 + 8 * hh;
#pragma unroll
            for (int kb = 0; kb < 2; ++kb)
#pragma unroll
                for (int s2 = 0; s2 < 2; ++s2) { const s16x4 lo = *(const LAS s16x4*)(vtp + (32 * kb + 16 * s2) * 2), hi = *(const LAS s16x4*)(vtp + (32 * kb + 16 * s2) * 2 + 16);
                    const bf16x8 va = __builtin_shufflevector(lo, hi, 0, 1, 2, 3, 4, 5, 6, 7);
                    pv = MFMA32(va, pf[kb][s2], pv); }
            const LAS unsigned char* ctp = L + (dir == 0 ? MO_C0 : MO_C1) + (32 * vb + r) * MO_S144 + 16 * hh;
#pragma unroll
            for (int ks = 0; ks < 4; ++ks) { const bf16x8 ca = *(const LAS bf16x8*)(ctp + 32 * ks); qc = MFMA32(ca, qf[ks], qc); }
#pragma unroll
            for (int i = 0; i < 16; ++i) hsum[i] += (pv[i] + a_t * qc[i]) * inv;
        }
        float ssq = 0.f;
#pragma unroll
        for (int i = 0; i < 16; ++i) ssq += hsum[i] * hsum[i];
        ssq = xsum32(ssq);
        if (hh == 0) part[(tb * 4 + vb) * 32 + r] = ssq;
        __syncthreads();
        const float tot = part[(tb * 4 + 0) * 32 + r] + part[(tb * 4 + 1) * 32 + r] + part[(tb * 4 + 2) * 32 + r] + part[(tb * 4 + 3) * 32 + r];
        const float rstd = 1.0f / sqrtf(tot * (1.0f / 128.0f) + RMS_EPS);
#pragma unroll
        for (int g = 0; g < 4; ++g) { const int v0 = 32 * vb + 8 * g + 4 * hh;
            const u32x2 og = *(const LAS u32x2*)(L + MO_O + tt * MO_S264 + v0 * 2); const f32x4 n4 = *(const f32x4*)(ng + h * 128 + v0);
            const unsigned ov = pk_fp8x4(hsum[4 * g] * rstd * n4[0] * bflo(og.x), hsum[4 * g + 1] * rstd * n4[1] * bfhi(og.x), hsum[4 * g + 2] * rstd * n4[2] * bflo(og.y), hsum[4 * g + 3] * rstd * n4[3] * bfhi(og.y));
            *(unsigned*)(HN + (size_t)trow * 1024 + h * 128 + v0) = ov; }
    }
#undef MO_LOAD
#undef MO_G
#undef MO_STORE
}

template <class T> __device__ __forceinline__ T* launder_ptr(T* p) {
    unsigned long long v = (unsigned long long)p; unsigned lo = __builtin_amdgcn_readfirstlane((unsigned)v), hi = __builtin_amdgcn_readfirstlane((unsigned)(v >> 32));
    asm volatile("" : "+s"(lo), "+s"(hi));
    lo = __builtin_amdgcn_readfirstlane(lo); hi = __builtin_amdgcn_readfirstlane(hi);
    return (T*)(__attribute__((address_space(1))) T*)(((unsigned long long)hi << 32) | lo);
}
__device__ __forceinline__ bool phase_enter(Frame& F, bool& did, const XcdBarrier& bar, bool sync) {
    if (did && sync) { if (!MK_PER_PHASE) xcd_barrier(bar); }
    did = true;
    F.ws = launder_ptr(F.ws); F.out = launder_ptr(F.out); F.ctl = launder_ptr(F.ctl);
    int t = F.tid; asm volatile("" : "+v"(t)); F.tid = t; F.lane = t & 63; F.wave = __builtin_amdgcn_readfirstlane(t >> 6);
    return true; }
__global__ void __launch_bounds__(512, 2) mk_fwd(Args args) {
    extern __shared__ __attribute__((aligned(16))) unsigned char lds[];
    Frame F;
    F.lds = (LAS unsigned char*)lds; F.MISC = (volatile LAS int*)(F.lds + MISC_OFF);
    F.tid = threadIdx.x; F.lane = F.tid & 63; F.wave = __builtin_amdgcn_readfirstlane(F.tid >> 6);
    F.G = gridDim.x; { const int bx = blockIdx.x; F.vcu = (F.G % 8 == 0) ? (bx % 8) * (F.G / 8) + bx / 8 : bx; }
    F.ws = args.ws; F.ctl = (unsigned*)(args.ws + WS_CTL); F.out = args.out;
    for (int u = F.tid; u < (LDS_BYTES - MISC_OFF) / 4; u += 512) F.MISC[u] = 0;
    __syncthreads();
    if (F.tid < 31) { const unsigned long long pv = (unsigned long long)args.in[F.tid]; F.MISC[MI_INP + 2 * F.tid] = (int)(unsigned)pv; F.MISC[MI_INP + 2 * F.tid + 1] = (int)(unsigned)(pv >> 32); }
    __syncthreads();
    XcdBarrier bar; bar.bar = F.ctl + CW_BAR; bar.x = 0; bar.st = nullptr;
    if (!MK_PER_PHASE) bar = xcd_barrier_post(F.ctl + CW_BAR, (volatile LAS unsigned*)(F.MISC + MI_BAR));
    const int lo = args.ph_lo, hi = args.ph_hi;
    bool did = false;
#ifndef EN_MASK
#define EN_MASK 0xffffffffu
#endif
#define PHASE(id, bit) if (((EN_MASK >> (bit)) & 1u) && (id) >= lo && (id) < hi && phase_enter(F, did, bar, true))
#define PHASE_NB(id, bit) if (((EN_MASK >> (bit)) & 1u) && (id) >= lo && (id) < hi && phase_enter(F, did, bar, false))
    LAS unsigned char* ring = F.lds;
    const int bx = blockIdx.x;

    PHASE(0, 0) { phase_prologue(F); }

    for (int layer = 0; layer < 4; ++layer) {
        const int kind = layer % 3, jl = layer / 3, pb = 32 * (layer + 1);
        const bool full = layer != 3;
        const int row_lo = full ? 0 : T_CTX, pm0 = full ? 0 : 8, nM = full ? 136 : 128;
        const bool ctx_post = layer < 2;
        const int row_lo_p = ctx_post ? 0 : T_CTX, pm0_p = ctx_post ? 0 : 8, nM_p = ctx_post ? 136 : 128;
        PHASE(pb + 0, 1) {
            if (layer == 0) phase_norm<true, false, 0>(F, layer, 0, row_lo, T_ALL);
            else if (kind == 1) phase_norm<false, true, 2>(F, layer, 0, row_lo, T_ALL);
            else phase_norm<false, true, 0>(F, layer, 0, row_lo, T_ALL);
        }
        if (kind == 0) {
            PHASE(pb + 2, 2) { pg8::SchedPlain S; S.init(WSP(bf16_t, WS_H), WSP(bf16_t, WS_WCIN) + (size_t)jl * 3072 * 1024, 1024, nM, 12, F.G, bx, pm0);
                pg8::EpiConvIn E{WSP(bf16_t, WS_A0), WSP(bf16_t, WS_A1)}; pg8::gemm_phase<pg8::EpiConvIn, pg8::SchedPlain, false>(ring, S, E, F.tid); }
            PHASE(pb + 4, 3) { phase_convz(F, jl, row_lo, T_ALL); }
        } else if (kind == 1) {
            PHASE(pb + 2, 4) {
                phase_ml_scan_gates(F);
                pg8::SchedPlain S; S.init(WSP(unsigned char, WS_XP), WSP(unsigned char, WS_WMLN), 512, 136, 8, F.G, bx, 0);
                pg8::EpiMlIn E{WSP(bf16_t, WS_A0), WSP(bf16_t, WS_A0) + (size_t)T_ALL * 512, WSP(bf16_t, WS_A1)}; pg8::gemm_phase<pg8::EpiMlIn, pg8::SchedPlain, true, true>(ring, S, E, F.tid); }
            PHASE_NB(pb + 3, 18) { pg8::SchedPlain S; S.init(WSP(unsigned char, WS_WMLS), WSP(unsigned char, WS_XP), 512, 6, 136, F.G, (bx + F.G - 64) % F.G, 0);
                pg8::EpiBf16 E{WSP(bf16_t, WS_A2), T_ALL, W8_INV, 1536}; pg8::gemm_phase<pg8::EpiBf16, pg8::SchedPlain, true, true>(ring, S, E, F.tid); }
            PHASE(pb + 4, 5) { phase_ml_state(F); }
            PHASE(pb + 6, 6) { phase_ml_out(F); }
        } else {
            PHASE(pb + 2, 7) { pg8::SchedPlain S; S.init(WSP(bf16_t, WS_H), WSP(bf16_t, WS_WDN), 1024, 136, 3, F.G, bx, 0);
                pg8::EpiBf16 E{WSP(bf16_t, WS_A0), 768, 1.0f, 0}; pg8::gemm_phase<pg8::EpiBf16, pg8::SchedPlain, false>(ring, S, E, F.tid); }
            PHASE(pb + 4, 8) { phase_mla_n1(F); }
            PHASE(pb + 6, 9) { pg8::SchedPlain S; S.init(WSP(bf16_t, WS_A6), WSP(bf16_t, WS_WUQ), 384, nM_p, 6, F.G, bx, pm0_p);
                pg8::EpiBf16 E{WSP(bf16_t, WS_A1), 1536, 1.0f, 0}; pg8::gemm_phase<pg8::EpiBf16, pg8::SchedPlain, false>(ring, S, E, F.tid); }
            PHASE_NB(pb + 7, 19) { pg8::SchedPlain S; S.init(WSP(bf16_t, WS_A6 + 26 * MiB), WSP(bf16_t, WS_WKN), 256, 136, 4, F.G, (bx + F.G - 48) % F.G, 0);
                pg8::EpiBf16 E{WSP(bf16_t, WS_A3), 1024, 1.0f, 0}; pg8::gemm_phase<pg8::EpiBf16, pg8::SchedPlain, false>(ring, S, E, F.tid); }
            PHASE_NB(pb + 8, 20) { pg8::SchedPlain S; S.init(WSP(bf16_t, WS_WV), WSP(bf16_t, WS_A6 + 26 * MiB), 256, 4, 136, F.G, (bx + F.G - 80) % F.G, 0);
                pg8::EpiVt8 E{WSP(unsigned char, WS_A5)}; pg8::gemm_phase<pg8::EpiVt8, pg8::SchedPlain, false>(ring, S, E, F.tid); }
            PHASE(pb + 9, 10) { phase_mla_n2(F); }
            PHASE(pb + 10, 11) { phase_attn(F, ctx_post); }
        }
        PHASE(pb + 12, 12) {
            const unsigned char* mixA = kind == 0 ? WSP(unsigned char, WS_A2) : (kind == 1 ? WSP(unsigned char, WS_A3) : WSP(unsigned char, WS_A6 + 50 * MiB));
            const unsigned char* mixW = kind == 0 ? WSP(unsigned char, WS_WCOUT) + (size_t)jl * 1024 * 1024 : (kind == 1 ? WSP(unsigned char, WS_WMLO) : WSP(unsigned char, WS_WMO));
            pg8::SchedPlain S; S.init(mixA, mixW, 512, nM_p, 4, F.G, bx, pm0_p);
            const float* sc = layer == 0 ? inp(F, IN_CTX) : nullptr; const float* sl = layer == 0 ? inp(F, IN_X) : nullptr;
            pg8::EpiResid E{sc, sl, WSP(bf16_t, WS_XB), WSP(float, WS_MOD) + (size_t)layer * 9 * 6144 + 2 * 1024};
            pg8::gemm_phase<pg8::EpiResid, pg8::SchedPlain, true, true>(ring, S, E, F.tid);
        }
        PHASE(pb + 14, 13) { phase_norm<false, false, 1>(F, layer, 1, row_lo_p, T_ALL); }
        PHASE(pb + 18, 15) {
            moe_tables(F, layer, true);
            pg8::SchedMoe S; S.A = (const char*)WSP(unsigned char, WS_XP); S.W = (const char*)(WSP(unsigned char, WS_W1) + (size_t)layer * 32 * 2048 * 1024); S.wstride = (size_t)2048 * 1024;
            S.K = 512; S.NT = 8; S.nunits = __builtin_amdgcn_readfirstlane(F.MISC[MI_PPRE + NEXP]) * 8; S.G = F.G; S.c = bx; S.ppre = (const LAS int*)(F.MISC + MI_PPRE); S.ecnt = (const LAS int*)(F.MISC + MI_CNT); S.list = WSP(int, WS_LIST); S.prep();
            pg8::EpiMoe1 E{WSP(unsigned char, WS_ACT), inp(F, IN_MOE_B1) + (size_t)layer * 32 * 2048};
            pg8::gemm_phase<pg8::EpiMoe1, pg8::SchedMoe, true, true>(ring, S, E, F.tid);
        }
        PHASE(pb + 20, 16) {
            moe_tables(F, layer, true);
            pg8::SchedMoe S; S.A = (const char*)WSP(unsigned char, WS_ACT); S.W = (const char*)(WSP(unsigned char, WS_W2) + (size_t)layer * 32 * 1024 * 1024); S.wstride = (size_t)1024 * 1024;
            S.K = 512; S.NT = 4; S.nunits = __builtin_amdgcn_readfirstlane(F.MISC[MI_PPRE + NEXP]) * 4; S.G = F.G; S.c = bx; S.ppre = (const LAS int*)(F.MISC + MI_PPRE); S.ecnt = (const LAS int*)(F.MISC + MI_CNT); S.list = nullptr; S.prep();
            pg8::EpiMoe2 E{WSP(unsigned char, WS_Y), inp(F, IN_MOE_B2) + (size_t)layer * 32 * 1024};
            pg8::gemm_phase<pg8::EpiMoe2, pg8::SchedMoe, true, true>(ring, S, E, F.tid);
        }
    }
    PHASE(1000, 17) { phase_final(F, 3); }
#undef PHASE
}

extern "C" void kernel_launch(void* const* d_in, const int* in_sizes, int n_in, void* d_out, int out_size, void* d_ws, size_t ws_size, hipStream_t stream) {
    static int grid = 0;
    if (grid == 0) {
        if (n_in != 31 || out_size != T_LAT * D || ws_size < WS_END) { fprintf(stderr, "kernel_launch: unexpected shapes (n_in %d out %d ws %zu)\n", n_in, out_size, ws_size); grid = -1; return; }
        int dev = 0, cus = 0;
        if (hipGetDevice(&dev) != hipSuccess || hipDeviceGetAttribute(&cus, hipDeviceAttributeMultiprocessorCount, dev) != hipSuccess) { grid = -1; return; }
        if (hipFuncSetAttribute((const void*)mk_fwd, hipFuncAttributeMaxDynamicSharedMemorySize, LDS_BYTES) != hipSuccess) { fprintf(stderr, "kernel_launch: hipFuncSetAttribute failed\n"); grid = -1; return; }
        int per_cu = 0;
        if (hipOccupancyMaxActiveBlocksPerMultiprocessor(&per_cu, (const void*)mk_fwd, 512, LDS_BYTES) != hipSuccess || per_cu < 1) fprintf(stderr, "kernel_launch: occupancy query says %d\n", per_cu);
        (void)hipGetLastError();
        grid = cus;
    }
    if (grid < 0) return;
    (void)hipMemsetAsync((char*)d_ws + WS_CTL, 0, CTL_ZERO_BYTES, stream);
    Args a{};
    for (int i = 0; i < 31; ++i) a.in[i] = (const float*)d_in[i];
    a.out = (float*)d_out; a.ws = (unsigned char*)d_ws;
#if MK_PER_PHASE
    static const int conv_ph[] = {0, 2, 4, 12, 14, 18, 20}, ml_ph[] = {0, 2, 3, 4, 6, 12, 14, 18, 20}, mla_ph[] = {0, 2, 4, 6, 7, 8, 9, 10, 12, 14, 18, 20};
    int ids[64]; int n = 0; ids[n++] = 0;
    for (int layer = 0; layer < 4; ++layer) { const int kind = layer % 3, pb = 32 * (layer + 1);
        if (kind == 0) for (int k : conv_ph) ids[n++] = pb + k; else if (kind == 1) for (int k : ml_ph) ids[n++] = pb + k; else for (int k : mla_ph) ids[n++] = pb + k; }
    ids[n++] = 1000;
#ifndef PROBE_IDS
#define PROBE_IDS
#endif
    static const int probe_ids[] = {-1, PROBE_IDS};
    for (int i = 0; i < n; ++i) { int reps = 1; for (int p : probe_ids) if (p == ids[i]) ++reps;
        for (int q = 0; q < reps; ++q) { a.ph_lo = ids[i]; a.ph_hi = ids[i] + 1; hipLaunchKernelGGL(mk_fwd, dim3(grid), dim3(512), LDS_BYTES, stream, a); } }
#else
    a.ph_lo = 0; a.ph_hi = 100000;
    hipLaunchKernelGGL(mk_fwd, dim3(grid), dim3(512), LDS_BYTES, stream, a);
#endif
}
```
